# Optimizing an MI355X kernel written in HIP

```python
import math
import jax, jax.numpy as jnp
from jax import lax
import numpy as np

D_MODEL = 2048
BATCH = 4
SEQ = 4096
DEPTH = 1

N_Q_HEADS = 16
N_KV_HEADS = 4
HEAD_DIM = 64
WINDOW = 128
ATTN_BLOCK = 128
N_BUCKETS = 32
MAX_DISTANCE = 128
GLA_HEADS = 4
GLA_DK = D_MODEL // 2 // GLA_HEADS
GLA_DV = D_MODEL // GLA_HEADS
GLA_LOWRANK = 16
GLA_NORMALIZER = 16.0
GLA_CHUNK = 64
D_FF = 5632
CONV_WIDTH = 3
EPS = 1e-6
NEG_INF = -1e30

ATTN_Q_W = N_Q_HEADS * HEAD_DIM
ATTN_KV_W = N_KV_HEADS * HEAD_DIM
GLA_K_W = GLA_HEADS * GLA_DK
GLA_V_W = GLA_HEADS * GLA_DV
IN_SPLITS = (ATTN_Q_W, ATTN_KV_W, ATTN_KV_W, GLA_K_W, GLA_K_W, GLA_V_W, GLA_V_W, GLA_LOWRANK, D_MODEL, D_MODEL)
D_IN = sum(IN_SPLITS)

kernel_name = "hybrid_swa_sink_gla_convffn_adaln"


def rms_norm(x, gain):
    xf = x.astype(jnp.float32)
    y = xf * lax.rsqrt(jnp.mean(xf * xf, axis=-1, keepdims=True) + EPS)
    return (y * gain.astype(jnp.float32)).astype(x.dtype)


def modulate(h, shift, scale):
    return h * (1 + scale[:, None, :]) + shift[:, None, :]


def t5_bucket(dist):
    max_exact = N_BUCKETS // 2
    d = jnp.maximum(dist, 0)
    large = max_exact + (jnp.log(jnp.maximum(d, 1).astype(jnp.float32) / max_exact)
                         / math.log(MAX_DISTANCE / max_exact) * (N_BUCKETS - max_exact)).astype(jnp.int32)
    large = jnp.minimum(large, N_BUCKETS - 1)
    return jnp.where(d < max_exact, d, large)


def sliding_window_attention(q, k, v, q_gain, k_gain, sinks, rel_bias_table):
    B, S = q.shape[0], q.shape[1]
    nb = S // ATTN_BLOCK
    G = N_Q_HEADS // N_KV_HEADS
    f32 = jnp.float32
    q = rms_norm(q, q_gain)
    k = rms_norm(k, k_gain)
    qb = q.reshape(B, nb, ATTN_BLOCK, N_KV_HEADS, G, HEAD_DIM)

    def band(t):
        tb = t.reshape(B, nb, ATTN_BLOCK, N_KV_HEADS, HEAD_DIM)
        prev = jnp.pad(tb, ((0, 0), (1, 0), (0, 0), (0, 0), (0, 0)))[:, :-1]
        return jnp.concatenate([prev, tb], axis=2)

    kb, vb = band(k), band(v)
    scores = jnp.einsum('bnqhgd,bnkhd->bhgnqk', qb, kb, preferred_element_type=f32) * (HEAD_DIM ** -0.5)

    i = jnp.arange(ATTN_BLOCK)[:, None]
    j = jnp.arange(2 * ATTN_BLOCK)[None, :]
    dist = i + ATTN_BLOCK - j
    in_window = (dist >= 0) & (dist < WINDOW)
    first_block = (jnp.arange(nb) == 0)[:, None, None]
    valid = in_window[None] & ~(first_block & (j < ATTN_BLOCK)[None])

    bias = rel_bias_table[t5_bucket(dist)].astype(f32)
    bias = bias.transpose(2, 0, 1).reshape(N_KV_HEADS, G, 1, ATTN_BLOCK, 2 * ATTN_BLOCK)
    scores = jnp.where(valid, scores + bias, NEG_INF)

    sink = sinks.astype(f32).reshape(N_KV_HEADS, G, 1, 1, 1)
    m = jnp.maximum(jnp.max(scores, axis=-1, keepdims=True), sink)
    p = jnp.exp(scores - m)
    probs = p / (jnp.sum(p, axis=-1, keepdims=True) + jnp.exp(sink - m))
    out = jnp.einsum('bhgnqk,bnkhd->bnqhgd', probs.astype(vb.dtype), vb)
    return out.reshape(B, S, ATTN_Q_W).astype(q.dtype)


def gated_linear_attention(q, k, v, gk_log, out_gate, o_gain):
    B, S = q.shape[0], q.shape[1]
    nc = S // GLA_CHUNK
    C = GLA_CHUNK
    f32 = jnp.float32

    def chunk(t):
        return t.astype(f32).reshape(B, nc, C, GLA_HEADS, t.shape[-1]).transpose(0, 3, 1, 2, 4)

    qc = chunk(q) * (GLA_DK ** -0.5)
    kc = chunk(k)
    vc = chunk(v)
    g = jnp.cumsum(chunk(gk_log), axis=3)
    g_last = g[:, :, :, -1:, :]
    q_dec = qc * jnp.exp(g)
    k_inv = kc * jnp.exp(-g)
    k_to_end = kc * jnp.exp(g_last - g)

    causal = jnp.tril(jnp.ones((C, C), dtype=bool))
    A = jnp.where(causal, jnp.einsum('bhnid,bhnjd->bhnij', q_dec, k_inv), 0.0)
    o_intra = jnp.einsum('bhnij,bhnjv->bhniv', A, vc)

    def step(state, inp):
        qd, kte, vv, decay = inp
        o = jnp.einsum('bhcd,bhdv->bhcv', qd, state)
        state = decay[..., None] * state + jnp.einsum('bhcd,bhcv->bhdv', kte, vv)
        return state, o

    xs = (jnp.moveaxis(q_dec, 2, 0), jnp.moveaxis(k_to_end, 2, 0), jnp.moveaxis(vc, 2, 0),
          jnp.moveaxis(jnp.exp(g_last[:, :, :, 0, :]), 2, 0))
    state0 = jnp.zeros((B, GLA_HEADS, GLA_DK, GLA_DV), f32)
    _, o_inter = lax.scan(step, state0, xs)
    o = o_intra + jnp.moveaxis(o_inter, 0, 2)
    o = o.transpose(0, 2, 3, 1, 4).reshape(B, S, GLA_HEADS, GLA_DV)
    o = rms_norm(o, o_gain) * jax.nn.silu(out_gate.astype(f32))
    return o.reshape(B, S, GLA_V_W).astype(q.dtype)


def conv_ffn(h, w_up, conv_w, conv_b, w_down):
    S = h.shape[1]
    u = h @ w_up
    up = jnp.pad(u, ((0, 0), (CONV_WIDTH - 1, 0), (0, 0)))
    y = conv_b
    for tap in range(CONV_WIDTH):
        y = y + conv_w[tap] * up[:, tap:tap + S]
    a, b = jnp.split(y, 2, axis=-1)
    return (jax.nn.silu(a) * b) @ w_down


def setup_inputs(seed: int = 0) -> dict:
    key = jax.random.key(seed)
    ks = jax.random.split(key, 24)
    f32 = jnp.float32
    L, D = DEPTH, D_MODEL

    def nrm(k, shape, scale):
        return jax.random.normal(k, shape, f32) * scale

    return {
        "x": nrm(ks[0], (BATCH, SEQ, D), 1.0),
        "c": nrm(ks[1], (BATCH, D), 1.0),
        "rel_bias_table": nrm(ks[2], (N_BUCKETS, N_Q_HEADS), 0.5),
        "w_ada": nrm(ks[3], (L, D, 6 * D), D ** -0.5),
        "b_ada": nrm(ks[4], (L, 6 * D), 0.02),
        "norm1_gain": 1.0 + nrm(ks[5], (L, D), 0.02),
        "w_in": nrm(ks[6], (L, D, D_IN), D ** -0.5),
        "q_norm_gain": 1.0 + nrm(ks[7], (L, HEAD_DIM), 0.02),
        "k_norm_gain": 1.0 + nrm(ks[8], (L, HEAD_DIM), 0.02),
        "attn_sinks": nrm(ks[9], (L, N_Q_HEADS), 0.5),
        "w_gk_up": nrm(ks[10], (L, GLA_LOWRANK, GLA_K_W), GLA_LOWRANK ** -0.5),
        "b_gk": nrm(ks[11], (L, GLA_K_W), 0.02),
        "gla_norm_gain": 1.0 + nrm(ks[12], (L, GLA_DV), 0.02),
        "w_branch_attn": nrm(ks[13], (L, ATTN_Q_W, D), ATTN_Q_W ** -0.5),
        "w_branch_gla": nrm(ks[14], (L, GLA_V_W, D), GLA_V_W ** -0.5),
        "w_out": nrm(ks[15], (L, D, D), D ** -0.5),
        "norm2_gain": 1.0 + nrm(ks[16], (L, D), 0.02),
        "w_ffn_up": nrm(ks[17], (L, D, 2 * D_FF), D ** -0.5),
        "ffn_conv_w": nrm(ks[18], (L, CONV_WIDTH, 2 * D_FF), CONV_WIDTH ** -0.5),
        "ffn_conv_b": nrm(ks[19], (L, 2 * D_FF), 0.02),
        "w_ffn_down": nrm(ks[20], (L, D_FF, D), D_FF ** -0.5),
    }


def reference(x, c, rel_bias_table, w_ada, b_ada, norm1_gain, w_in, q_norm_gain, k_norm_gain,
              attn_sinks, w_gk_up, b_gk, gla_norm_gain, w_branch_attn, w_branch_gla, w_out,
              norm2_gain, w_ffn_up, ffn_conv_w, ffn_conv_b, w_ffn_down):
    B, S = x.shape[0], x.shape[1]
    offsets = []
    acc = 0
    for width in IN_SPLITS[:-1]:
        acc += width
        offsets.append(acc)
    c_act = jax.nn.silu(c)

    for l in range(DEPTH):
        mod = c_act @ w_ada[l] + b_ada[l]
        shift1, scale1, gate1, shift2, scale2, gate2 = jnp.split(mod, 6, axis=-1)

        h = modulate(rms_norm(x, norm1_gain[l]), shift1, scale1)
        proj = h @ w_in[l]
        aq, ak, av, gq, gk, gv, gr, glr, ga, gb = jnp.split(proj, offsets, axis=-1)

        y_attn = sliding_window_attention(
            aq.reshape(B, S, N_Q_HEADS, HEAD_DIM),
            ak.reshape(B, S, N_KV_HEADS, HEAD_DIM),
            av.reshape(B, S, N_KV_HEADS, HEAD_DIM),
            q_norm_gain[l], k_norm_gain[l], attn_sinks[l], rel_bias_table)

        gk_log = jax.nn.log_sigmoid((glr @ w_gk_up[l] + b_gk[l]).astype(jnp.float32)) / GLA_NORMALIZER
        y_gla = gated_linear_attention(
            gq.reshape(B, S, GLA_HEADS, GLA_DK),
            gk.reshape(B, S, GLA_HEADS, GLA_DK),
            gv.reshape(B, S, GLA_HEADS, GLA_DV),
            gk_log.reshape(B, S, GLA_HEADS, GLA_DK),
            gr.reshape(B, S, GLA_HEADS, GLA_DV),
            gla_norm_gain[l])

        merged = (jax.nn.sigmoid(ga) * (y_attn @ w_branch_attn[l])
                  + jax.nn.sigmoid(gb) * (y_gla @ w_branch_gla[l]))
        x = x + gate1[:, None, :] * (merged @ w_out[l])

        h2 = modulate(rms_norm(x, norm2_gain[l]), shift2, scale2)
        x = x + gate2[:, None, :] * conv_ffn(h2, w_ffn_up[l], ffn_conv_w[l], ffn_conv_b[l], w_ffn_down[l])
    return x
```

```cpp
#include <hip/hip_runtime.h>
#include <hip/hip_cooperative_groups.h>
#include <cstdio>
#include <cstdint>
namespace cg = cooperative_groups;

namespace pg8 {
#define PG8_LAS __attribute__((address_space(3)))
typedef unsigned short bf16_t;
typedef short bf16x8 __attribute__((ext_vector_type(8)));
typedef float f32x4 __attribute__((ext_vector_type(4)));
typedef unsigned u32x4 __attribute__((ext_vector_type(4)));
constexpr int BM = 256, BK = 64, HALF = 128, HTB = HALF * BK * 2, STAGE_BYTES = 8 * HTB, NXCD = 8, WGM = 4;

__host__ __device__ __forceinline__ int lds_byte(int r, int c) { const int st = (r >> 4) * 2 + (c >> 5), rr = r & 15, cc = c & 31, ob = rr * 64 + cc * 2; return st * 1024 + (ob ^ (((ob >> 9) & 1) << 5)); }
__host__ __device__ __forceinline__ void stage_rc(int b, int& R, int& C) { const int st = b / 1024, sb = b % 1024, swz = sb ^ (((sb >> 9) & 1) << 5); R = (st >> 1) * 16 + swz / 64; C = (st & 1) * 32 + (swz % 64) / 2; }
__host__ __device__ __forceinline__ int perm32(int rho) { const int n = rho >> 4, i = rho & 15; return 8 * (i >> 2) + 4 * n + (i & 3); }

struct Unit { int pm, pn; };
struct Gemm { const bf16_t* A; const bf16_t* Bt; int M, N, K; };

struct StaticOrder {
    int nM, nN, nwg, G, c, wgm;
    __host__ __device__ void init(int M, int N, int G_, int c_, int wgm_ = WGM) { nM = M / BM; nN = N / BM; nwg = nM * nN; G = G_; c = c_; wgm = wgm_; }
    __host__ __device__ bool next(int i, Unit& u) const {
        const long L = (long)i * G + c; if (L >= nwg) return false;
        int wgid = (int)L; { const int q = nwg / NXCD, r = nwg % NXCD, xcd = wgid % NXCD, off = wgid / NXCD; wgid = (xcd < r ? xcd * (q + 1) : r * (q + 1) + (xcd - r) * q) + off; }
        const int nig = wgm * nN, gid = wgid / nig, fm = gid * wgm, gsz = (nM - fm) < wgm ? (nM - fm) : wgm;
        u.pm = fm + ((wgid % nig) % gsz); u.pn = (wgid % nig) / gsz; return true;
    }
};

__device__ __forceinline__ unsigned cvt_pk_bf16(float lo, float hi) { unsigned r; asm volatile("v_cvt_pk_bf16_f32 %0, %1, %2" : "=v"(r) : "v"(lo), "v"(hi)); return r; }

template <class Epi, class Sched, bool ALIGN_EPI = false, bool SP2 = false>
__device__ __forceinline__ void gemm_phase(PG8_LAS unsigned char* lds, const Gemm g, const Sched& S, const Epi& E) {
    const int tid = threadIdx.x, wid = __builtin_amdgcn_readfirstlane(tid >> 6), lane = tid & 63, wr = wid >> 2, wc = wid & 3, fr = lane & 15, fq = lane >> 4;
    const int K = g.K, nt = K / BK;
    unsigned voffA[2], voffB[2];
#pragma unroll
    for (int i = 0; i < 2; ++i) { int R, C; stage_rc(tid * 16 + i * 8192, R, C); const int Rb = 64 * (R >> 5) + (Epi::PERM ? perm32(R & 31) : (R & 31));
        const int Ra = Epi::ROWP ? ((R & 64) + 4 * (R & 15) + ((R >> 4) & 3)) : R;
        voffA[i] = (unsigned)(Ra * K + C) * 2u; voffB[i] = (unsigned)(Rb * K + C) * 2u; }
    const size_t kstep = (size_t)(BK * 2);
    const size_t hstep = (size_t)HALF * K * 2;
    const size_t hstepB = (size_t)32 * K * 2;
    const size_t tstep = (size_t)BM * K * 2;
    const unsigned ldsw = (unsigned)wid * 1024u;
    const int aoff = lds_byte(wr * 64 + fr, fq * 8), boff = lds_byte(wc * 32 + fr, fq * 8);
#define PG8_SA(b, h) (((b) * 2 + (h)) * HTB)
#define PG8_SB(b, h) ((4 + (b) * 2 + (h)) * HTB)
#define PG8_STAGE(bufoff, gbase, voff) do { _Pragma("unroll") for (int _i = 0; _i < 2; ++_i) \
        __builtin_amdgcn_global_load_lds((const unsigned*)((const char*)(gbase) + (voff)[_i]), (PG8_LAS unsigned*)(lds + (bufoff) + ldsw + _i * 8192), 16, 0, 0); } while (0)
#define PG8_LDA(dst, b, h) do { _Pragma("unroll") for (int m = 0; m < 4; ++m) _Pragma("unroll") for (int k = 0; k < 2; ++k) dst[m][k] = *(const PG8_LAS bf16x8*)(lds + PG8_SA(b, h) + aoff + m * 2048 + k * 1024); } while (0)
#define PG8_LDB(dst, b, h) do { _Pragma("unroll") for (int n = 0; n < 2; ++n) _Pragma("unroll") for (int k = 0; k < 2; ++k) dst[n][k] = *(const PG8_LAS bf16x8*)(lds + PG8_SB(b, h) + boff + n * 2048 + k * 1024); } while (0)
#define PG8_MMA(ai, bj, At, Bt) do { __builtin_amdgcn_s_setprio(1); _Pragma("unroll") for (int m = 0; m < 4; ++m) _Pragma("unroll") for (int n = 0; n < 2; ++n) _Pragma("unroll") for (int k = 0; k < 2; ++k) \
        acc[ai][bj][m][n] = __builtin_amdgcn_mfma_f32_16x16x32_bf16(Bt[n][k], At[m][k], acc[ai][bj][m][n], 0, 0, 0); __builtin_amdgcn_s_setprio(0); } while (0)
#define PG8_WAIT_V(n) asm volatile("s_waitcnt vmcnt(" #n ")" ::: "memory")
#define PG8_WAIT_L(n) asm volatile("s_waitcnt lgkmcnt(" #n ")" ::: "memory")
#define PG8_BAR __builtin_amdgcn_s_barrier()
#define PG8_SCHED __builtin_amdgcn_sched_barrier(0)
    Unit cur, nxt; int ui = 0;
    if (!S.next(0, cur)) return;
    f32x4 acc[2][2][4][2];
#pragma unroll
    for (int a = 0; a < 2; ++a)
#pragma unroll
        for (int b = 0; b < 2; ++b)
#pragma unroll
            for (int m = 0; m < 4; ++m)
#pragma unroll
                for (int n = 0; n < 2; ++n) acc[a][b][m][n] = (f32x4){0.f, 0.f, 0.f, 0.f};
    bf16x8 At[4][2], B0[2][2], B1[2][2];
    const char* cA = (const char*)g.A + (size_t)cur.pm * tstep; const char* cB = (const char*)g.Bt + (size_t)cur.pn * tstep;
    if constexpr (SP2) {
        PG8_STAGE(PG8_SB(0, 0), cB, voffB); PG8_STAGE(PG8_SB(0, 1), cB + hstepB, voffB); PG8_STAGE(PG8_SA(0, 0), cA, voffA); PG8_STAGE(PG8_SA(0, 1), cA + hstep, voffA);
        if (wr == 1) PG8_BAR;
        PG8_WAIT_V(2); PG8_BAR;
        PG8_STAGE(PG8_SB(1, 0), cB + kstep, voffB); PG8_STAGE(PG8_SA(1, 0), cA + kstep, voffA); PG8_STAGE(PG8_SB(1, 1), cB + hstepB + kstep, voffB);
        PG8_WAIT_V(6); PG8_BAR;
    } else {
        PG8_STAGE(PG8_SB(0, 0), cB, voffB); PG8_STAGE(PG8_SA(0, 0), cA, voffA); PG8_STAGE(PG8_SB(0, 1), cB + hstepB, voffB); PG8_STAGE(PG8_SA(0, 1), cA + hstep, voffA);
        if (wr == 1) PG8_BAR;
        PG8_WAIT_V(4); PG8_BAR;
        PG8_STAGE(PG8_SB(1, 0), cB + kstep, voffB); PG8_STAGE(PG8_SA(1, 0), cA + kstep, voffA); PG8_STAGE(PG8_SB(1, 1), cB + hstepB + kstep, voffB);
        PG8_WAIT_V(6); PG8_BAR;
    }
    for (;;) {
        const bool has_next = S.next(ui + 1, nxt);
        const char* nA = has_next ? (const char*)g.A + (size_t)nxt.pm * tstep : cA; const char* nB = has_next ? (const char*)g.Bt + (size_t)nxt.pn * tstep : cB;
        for (int t = 0; t < nt; t += 2) {
            const bool last = (t == nt - 2);
            const char* a1 = cA + (size_t)(t + 1) * kstep;
            const char* a2 = last ? nA : cA + (size_t)(t + 2) * kstep; const char* b2 = last ? nB : cB + (size_t)(t + 2) * kstep;
            const char* a3 = a2 + kstep; const char* b3 = b2 + kstep;
            if constexpr (SP2) {
            PG8_LDB(B0, 0, 0); PG8_LDB(B1, 0, 1); PG8_SCHED; PG8_LDA(At, 0, 0); PG8_STAGE(PG8_SA(1, 1), a1 + hstep, voffA);
            PG8_WAIT_V(8); PG8_WAIT_L(0); PG8_BAR; PG8_MMA(0, 0, At, B0); PG8_MMA(0, 1, At, B1); PG8_BAR; PG8_SCHED;
            PG8_LDA(At, 0, 1); PG8_STAGE(PG8_SB(0, 0), b2, voffB); PG8_STAGE(PG8_SB(0, 1), b2 + hstepB, voffB); PG8_STAGE(PG8_SA(0, 0), a2, voffA);
            PG8_WAIT_V(8); PG8_WAIT_L(0); PG8_BAR; PG8_MMA(1, 0, At, B0); PG8_MMA(1, 1, At, B1); PG8_BAR; PG8_SCHED;
            PG8_LDB(B0, 1, 0); PG8_LDB(B1, 1, 1); PG8_SCHED; PG8_LDA(At, 1, 0); PG8_STAGE(PG8_SA(0, 1), a2 + hstep, voffA);
            PG8_WAIT_V(8); PG8_WAIT_L(0); PG8_BAR; PG8_MMA(0, 0, At, B0); PG8_MMA(0, 1, At, B1); PG8_BAR; PG8_SCHED;
            PG8_LDA(At, 1, 1); PG8_STAGE(PG8_SB(1, 0), b3, voffB); PG8_STAGE(PG8_SB(1, 1), b3 + hstepB, voffB); PG8_STAGE(PG8_SA(1, 0), a3, voffA);
            PG8_WAIT_V(8); PG8_WAIT_L(0); PG8_BAR; PG8_MMA(1, 0, At, B0); PG8_MMA(1, 1, At, B1); PG8_BAR; PG8_SCHED;
            } else {
            PG8_LDB(B0, 0, 0); PG8_SCHED; PG8_LDA(At, 0, 0); PG8_STAGE(PG8_SA(1, 1), a1 + hstep, voffA);
            PG8_WAIT_L(8); PG8_BAR; PG8_WAIT_L(0); PG8_MMA(0, 0, At, B0); PG8_BAR; PG8_SCHED;
            PG8_LDB(B1, 0, 1); PG8_STAGE(PG8_SB(0, 0), b2, voffB);
            PG8_BAR; PG8_WAIT_L(0); PG8_MMA(0, 1, At, B1); PG8_BAR;
            PG8_LDA(At, 0, 1); PG8_STAGE(PG8_SA(0, 0), a2, voffA);
            PG8_BAR; PG8_WAIT_L(0); PG8_MMA(1, 0, At, B0); PG8_BAR; PG8_SCHED;
            PG8_STAGE(PG8_SB(0, 1), b2 + hstepB, voffB);
            PG8_WAIT_V(6); PG8_BAR; PG8_MMA(1, 1, At, B1); PG8_BAR;
            PG8_LDB(B0, 1, 0); PG8_SCHED; PG8_LDA(At, 1, 0); PG8_STAGE(PG8_SA(0, 1), a2 + hstep, voffA);
            PG8_WAIT_L(8); PG8_BAR; PG8_WAIT_L(0); PG8_MMA(0, 0, At, B0); PG8_BAR; PG8_SCHED;
            PG8_LDB(B1, 1, 1); PG8_STAGE(PG8_SB(1, 0), b3, voffB);
            PG8_BAR; PG8_WAIT_L(0); PG8_MMA(0, 1, At, B1); PG8_BAR;
            PG8_LDA(At, 1, 1); PG8_STAGE(PG8_SA(1, 0), a3, voffA);
            PG8_BAR; PG8_WAIT_L(0); PG8_MMA(1, 0, At, B0); PG8_BAR; PG8_SCHED;
            PG8_STAGE(PG8_SB(1, 1), b3 + hstepB, voffB);
            PG8_WAIT_V(6); PG8_BAR; PG8_MMA(1, 1, At, B1); PG8_BAR;
            }
        }
        if constexpr (ALIGN_EPI) { if (wr == 0) PG8_BAR; }
        E(acc, cur, wr, wc, fr, fq);
        if (!has_next) break;
#pragma unroll
        for (int a = 0; a < 2; ++a)
#pragma unroll
            for (int b = 0; b < 2; ++b)
#pragma unroll
                for (int m = 0; m < 4; ++m)
#pragma unroll
                    for (int n = 0; n < 2; ++n) acc[a][b][m][n] = (f32x4){0.f, 0.f, 0.f, 0.f};
        cur = nxt; cA = nA; cB = nB; ++ui;
        if constexpr (ALIGN_EPI) { if (wr == 1) PG8_BAR; }
    }
    PG8_WAIT_V(0);
    if constexpr (!ALIGN_EPI) { if (wr == 0) PG8_BAR; }
    PG8_BAR;
#undef PG8_SA
#undef PG8_SB
#undef PG8_STAGE
#undef PG8_LDA
#undef PG8_LDB
#undef PG8_MMA
#undef PG8_WAIT_V
#undef PG8_WAIT_L
#undef PG8_BAR
#undef PG8_SCHED
}
struct Gemm2 { const bf16_t* A0; const bf16_t* B0; int K0; const bf16_t* A1; const bf16_t* B1; int K1; };
template <class Epi, class Sched>
__device__ __forceinline__ void gemm_phase2(PG8_LAS unsigned char* lds, const Gemm2 g, const Sched& S, const Epi& E) {
    const int tid = threadIdx.x, wid = __builtin_amdgcn_readfirstlane(tid >> 6), lane = tid & 63, wr = wid >> 2, wc = wid & 3, fr = lane & 15, fq = lane >> 4;
    unsigned vA0[2], vB0[2], vA1[2], vB1[2];
#pragma unroll
    for (int i = 0; i < 2; ++i) { int R, C; stage_rc(tid * 16 + i * 8192, R, C); const int Rb = 64 * (R >> 5) + (Epi::PERM ? perm32(R & 31) : (R & 31));
        vA0[i] = (unsigned)(R * g.K0 + C) * 2u; vB0[i] = (unsigned)(Rb * g.K0 + C) * 2u; vA1[i] = (unsigned)(R * g.K1 + C) * 2u; vB1[i] = (unsigned)(Rb * g.K1 + C) * 2u; }
    const size_t kstep = (size_t)(BK * 2);
    const size_t hA0 = (size_t)HALF * g.K0 * 2, hB0 = (size_t)32 * g.K0 * 2, ts0 = (size_t)BM * g.K0 * 2;
    const size_t hA1 = (size_t)HALF * g.K1 * 2, hB1 = (size_t)32 * g.K1 * 2, ts1 = (size_t)BM * g.K1 * 2;
    const unsigned ldsw = (unsigned)wid * 1024u;
    const int aoff = lds_byte(wr * 64 + fr, fq * 8), boff = lds_byte(wc * 32 + fr, fq * 8);
#define PG8_SA(b, h) (((b) * 2 + (h)) * HTB)
#define PG8_SB(b, h) ((4 + (b) * 2 + (h)) * HTB)
#define PG8_STAGE(bufoff, gbase, voff) do { _Pragma("unroll") for (int _i = 0; _i < 2; ++_i) \
        __builtin_amdgcn_global_load_lds((const unsigned*)((const char*)(gbase) + (voff)[_i]), (PG8_LAS unsigned*)(lds + (bufoff) + ldsw + _i * 8192), 16, 0, 0); } while (0)
#define PG8_LDA(dst, b, h) do { _Pragma("unroll") for (int m = 0; m < 4; ++m) _Pragma("unroll") for (int k = 0; k < 2; ++k) dst[m][k] = *(const PG8_LAS bf16x8*)(lds + PG8_SA(b, h) + aoff + m * 2048 + k * 1024); } while (0)
#define PG8_LDB(dst, b, h) do { _Pragma("unroll") for (int n = 0; n < 2; ++n) _Pragma("unroll") for (int k = 0; k < 2; ++k) dst[n][k] = *(const PG8_LAS bf16x8*)(lds + PG8_SB(b, h) + boff + n * 2048 + k * 1024); } while (0)
#define PG8_MMA(ai, bj, At, Bt) do { __builtin_amdgcn_s_setprio(1); _Pragma("unroll") for (int m = 0; m < 4; ++m) _Pragma("unroll") for (int n = 0; n < 2; ++n) _Pragma("unroll") for (int k = 0; k < 2; ++k) \
        acc[ai][bj][m][n] = __builtin_amdgcn_mfma_f32_16x16x32_bf16(Bt[n][k], At[m][k], acc[ai][bj][m][n], 0, 0, 0); __builtin_amdgcn_s_setprio(0); } while (0)
#define PG8_WAIT_V(n) asm volatile("s_waitcnt vmcnt(" #n ")" ::: "memory")
#define PG8_WAIT_L(n) asm volatile("s_waitcnt lgkmcnt(" #n ")" ::: "memory")
#define PG8_BAR __builtin_amdgcn_s_barrier()
#define PG8_SCHED __builtin_amdgcn_sched_barrier(0)
    Unit cur, nxt; int ui = 0, seg = 0;
    if (!S.next(0, cur)) return;
    f32x4 acc[2][2][4][2];
#pragma unroll
    for (int a = 0; a < 2; ++a)
#pragma unroll
        for (int b = 0; b < 2; ++b)
#pragma unroll
            for (int m = 0; m < 4; ++m)
#pragma unroll
                for (int n = 0; n < 2; ++n) acc[a][b][m][n] = (f32x4){0.f, 0.f, 0.f, 0.f};
    bf16x8 At[4][2], B0[2][2], B1[2][2];
    const char* cA = (const char*)g.A0 + (size_t)cur.pm * ts0; const char* cB = (const char*)g.B0 + (size_t)cur.pn * ts0;
    unsigned cvA[2] = {vA0[0], vA0[1]}, cvB[2] = {vB0[0], vB0[1]}; size_t chA = hA0, chB = hB0; int nt = g.K0 / BK;
    PG8_STAGE(PG8_SB(0, 0), cB, cvB); PG8_STAGE(PG8_SB(0, 1), cB + chB, cvB); PG8_STAGE(PG8_SA(0, 0), cA, cvA); PG8_STAGE(PG8_SA(0, 1), cA + chA, cvA);
    if (wr == 1) PG8_BAR;
    PG8_WAIT_V(2); PG8_BAR;
    PG8_STAGE(PG8_SB(1, 0), cB + kstep, cvB); PG8_STAGE(PG8_SA(1, 0), cA + kstep, cvA); PG8_STAGE(PG8_SB(1, 1), cB + chB + kstep, cvB);
    PG8_WAIT_V(6); PG8_BAR;
    for (;;) {
        bool has_next = true; const char* nA; const char* nB; unsigned nvA[2], nvB[2]; size_t nhA, nhB; int nnt;
        if (seg == 0) { nA = (const char*)g.A1 + (size_t)cur.pm * ts1; nB = (const char*)g.B1 + (size_t)cur.pn * ts1; nvA[0] = vA1[0]; nvA[1] = vA1[1]; nvB[0] = vB1[0]; nvB[1] = vB1[1]; nhA = hA1; nhB = hB1; nnt = g.K1 / BK; }
        else { has_next = S.next(ui + 1, nxt);
            if (has_next) { nA = (const char*)g.A0 + (size_t)nxt.pm * ts0; nB = (const char*)g.B0 + (size_t)nxt.pn * ts0; nvA[0] = vA0[0]; nvA[1] = vA0[1]; nvB[0] = vB0[0]; nvB[1] = vB0[1]; nhA = hA0; nhB = hB0; nnt = g.K0 / BK; }
            else { nA = cA; nB = cB; nvA[0] = cvA[0]; nvA[1] = cvA[1]; nvB[0] = cvB[0]; nvB[1] = cvB[1]; nhA = chA; nhB = chB; nnt = nt; } }
        for (int t = 0; t < nt; t += 2) {
            const bool last = (t == nt - 2);
            const char* a1 = cA + (size_t)(t + 1) * kstep;
            const char* a2 = last ? nA : cA + (size_t)(t + 2) * kstep; const char* b2 = last ? nB : cB + (size_t)(t + 2) * kstep;
            const char* a3 = a2 + kstep; const char* b3 = b2 + kstep;
            unsigned xA[2], xB[2]; xA[0] = last ? nvA[0] : cvA[0]; xA[1] = last ? nvA[1] : cvA[1]; xB[0] = last ? nvB[0] : cvB[0]; xB[1] = last ? nvB[1] : cvB[1];
            const size_t xhA = last ? nhA : chA, xhB = last ? nhB : chB;
            PG8_LDB(B0, 0, 0); PG8_LDB(B1, 0, 1); PG8_SCHED; PG8_LDA(At, 0, 0); PG8_STAGE(PG8_SA(1, 1), a1 + chA, cvA);
            PG8_WAIT_V(8); PG8_WAIT_L(0); PG8_BAR; PG8_MMA(0, 0, At, B0); PG8_MMA(0, 1, At, B1); PG8_BAR; PG8_SCHED;
            PG8_LDA(At, 0, 1); PG8_STAGE(PG8_SB(0, 0), b2, xB); PG8_STAGE(PG8_SB(0, 1), b2 + xhB, xB); PG8_STAGE(PG8_SA(0, 0), a2, xA);
            PG8_WAIT_V(8); PG8_WAIT_L(0); PG8_BAR; PG8_MMA(1, 0, At, B0); PG8_MMA(1, 1, At, B1); PG8_BAR; PG8_SCHED;
            PG8_LDB(B0, 1, 0); PG8_LDB(B1, 1, 1); PG8_SCHED; PG8_LDA(At, 1, 0); PG8_STAGE(PG8_SA(0, 1), a2 + xhA, xA);
            PG8_WAIT_V(8); PG8_WAIT_L(0); PG8_BAR; PG8_MMA(0, 0, At, B0); PG8_MMA(0, 1, At, B1); PG8_BAR; PG8_SCHED;
            PG8_LDA(At, 1, 1); PG8_STAGE(PG8_SB(1, 0), b3, xB); PG8_STAGE(PG8_SB(1, 1), b3 + xhB, xB); PG8_STAGE(PG8_SA(1, 0), a3, xA);
            PG8_WAIT_V(8); PG8_WAIT_L(0); PG8_BAR; PG8_MMA(1, 0, At, B0); PG8_MMA(1, 1, At, B1); PG8_BAR; PG8_SCHED;
        }
        if (wr == 0) PG8_BAR;
        if (seg == 0) E.mid(acc, cur, wr, wc, fr, fq); else E(acc, cur, wr, wc, fr, fq);
        if (seg == 1 && !has_next) break;
        if (seg == 1) {
#pragma unroll
            for (int a = 0; a < 2; ++a)
#pragma unroll
                for (int b = 0; b < 2; ++b)
#pragma unroll
                    for (int m = 0; m < 4; ++m)
#pragma unroll
                        for (int n = 0; n < 2; ++n) acc[a][b][m][n] = (f32x4){0.f, 0.f, 0.f, 0.f};
            cur = nxt; ++ui; }
        seg ^= 1; cA = nA; cB = nB; cvA[0] = nvA[0]; cvA[1] = nvA[1]; cvB[0] = nvB[0]; cvB[1] = nvB[1]; chA = nhA; chB = nhB; nt = nnt;
        if (wr == 1) PG8_BAR;
    }
    PG8_WAIT_V(0);
    PG8_BAR;
#undef PG8_SA
#undef PG8_SB
#undef PG8_STAGE
#undef PG8_LDA
#undef PG8_LDB
#undef PG8_MMA
#undef PG8_WAIT_V
#undef PG8_WAIT_L
#undef PG8_BAR
#undef PG8_SCHED
}
}

#define P2_WGM 4
#define P7_WGM 4
#define P8_WGM 4
#define P10_WGM 8
#define P12_WGM 4
#ifndef PG8_SP2V
#define PG8_SP2V true
#endif
typedef unsigned short bf16;
typedef float f32x4 __attribute__((ext_vector_type(4)));
typedef unsigned u32x4 __attribute__((ext_vector_type(4)));
typedef unsigned u32x2 __attribute__((ext_vector_type(2)));
#define LAS __attribute__((address_space(3)))
constexpr int NWAVES = 8, NT_BLK = 512;
constexpr int DM = 2048, BATCH = 4, SEQ = 4096, M = BATCH * SEQ;
constexpr int D_IN = 11792, NIN_PAD = 12032;
constexpr int DFF = 5632, NUP = 2 * DFF;
constexpr int NMOD = 6 * DM;
constexpr float EPS = 1e-6f;
constexpr int ADA_KS = 32;

constexpr size_t MiB = 1u << 20;
constexpr size_t WS_MODP = 64 * 1024;
constexpr size_t WS_MODF = 0 * MiB + 65536;
constexpr size_t WS_WIN  = 2 * MiB;
constexpr size_t WS_YATT = 2 * MiB;
constexpr size_t WS_XN   = 49 * MiB;
constexpr size_t WS_O    = 182 * MiB;
constexpr size_t WS_AM = 34 * MiB, WS_DEC = 42 * MiB, WS_QD = 49 * MiB, WS_KTET = 81 * MiB;
constexpr size_t WS_WBA  = 113 * MiB, WS_WBG = 117 * MiB, WS_WOUT = 125 * MiB;
constexpr size_t WS_GLR  = 133 * MiB;
constexpr size_t WS_AQ = 134 * MiB, WS_AK = 166 * MiB, WS_AV = 174 * MiB, WS_GQ = 182 * MiB, WS_GK = 214 * MiB;
constexpr size_t WS_GV = 246 * MiB, WS_GR = 310 * MiB;
constexpr size_t WS_MODP2 = 502 * MiB;
constexpr size_t WS_M1   = 49 * MiB;
constexpr size_t WS_MRG  = 310 * MiB;
constexpr size_t WS_WUP  = 374 * MiB;
constexpr size_t WS_WDN  = 418 * MiB;
constexpr size_t WS_ACT  = 113 * MiB;
constexpr size_t WS_HALO = 290 * MiB;
constexpr size_t WS_X1B  = 440 * MiB;
constexpr size_t WS_END  = 512 * MiB;

constexpr int LDS_BYTES = 163840;

__device__ __forceinline__ float bf2f(unsigned v) { return __uint_as_float(v << 16); }
__device__ __forceinline__ unsigned f2bf(float f) { unsigned u = __float_as_uint(f); return (u + 0x7fffu + ((u >> 16) & 1u)) >> 16; }
typedef float f32x2_t __attribute__((ext_vector_type(2))); typedef __bf16 bf16x2_t __attribute__((ext_vector_type(2)));
__device__ __forceinline__ unsigned pk2(float lo, float hi) { f32x2_t v = {lo, hi}; bf16x2_t b = __builtin_convertvector(v, bf16x2_t); return __builtin_bit_cast(unsigned, b); }
__device__ __forceinline__ float sigmoidf_(float x) { return __builtin_amdgcn_rcpf(1.f + __builtin_amdgcn_exp2f(-1.4426950408889634f * x)); }
__device__ __forceinline__ float wave_sum(float v) {
#pragma unroll
    for (int o = 1; o < 64; o <<= 1) v += __shfl_xor(v, o);
    return v;
}
__device__ __forceinline__ void unpack8(const u32x4 w, float (&f)[8]) {
    f[0] = bf2f(w.x & 0xffffu); f[1] = bf2f(w.x >> 16); f[2] = bf2f(w.y & 0xffffu); f[3] = bf2f(w.y >> 16);
    f[4] = bf2f(w.z & 0xffffu); f[5] = bf2f(w.z >> 16); f[6] = bf2f(w.w & 0xffffu); f[7] = bf2f(w.w >> 16);
}

__device__ __forceinline__ void unpack8u(const u32x2 w, float (&f)[8]) {
    const float k = 1.0f / 255.0f;
    f[0] = (float)(w.x & 0xffu) * k; f[1] = (float)((w.x >> 8) & 0xffu) * k; f[2] = (float)((w.x >> 16) & 0xffu) * k; f[3] = (float)(w.x >> 24) * k;
    f[4] = (float)(w.y & 0xffu) * k; f[5] = (float)((w.y >> 8) & 0xffu) * k; f[6] = (float)((w.y >> 16) & 0xffu) * k; f[7] = (float)(w.y >> 24) * k;
}
using pg8::Unit;
struct EpiInProj {
    static constexpr bool PERM = true; static constexpr bool ROWP = false;
    bf16 *AQ, *AK, *AV, *GQ, *GK, *GV, *GR; unsigned char *GA, *GB; float* GLR; const float *qg, *kg;
    __device__ __forceinline__ void operator()(const f32x4 (&acc)[2][2][4][2], const Unit& u, int wr, int wc, int fr, int fq) const {
        const int pn = u.pn; const int rowb = u.pm * 256 + wr * 64 + fr; const int cw = 64 * wc + 8 * fq;
        if (pn < 5) {
            bf16* dst; int ld; const float* gain; float sc;
            if (pn < 4) { dst = AQ + pn * 256; ld = 1024; gain = qg; sc = 0.125f; } else { dst = AK; ld = 256; gain = kg; sc = 1.f; }
            f32x4 g[2][2];
#pragma unroll
            for (int bj = 0; bj < 2; ++bj)
#pragma unroll
                for (int n = 0; n < 2; ++n) g[bj][n] = *(const f32x4*)(gain + 32 * bj + 8 * fq + 4 * n) * sc;
#pragma unroll
            for (int ai = 0; ai < 2; ++ai)
#pragma unroll
                for (int m = 0; m < 4; ++m) {
                    float ss = 0.f;
#pragma unroll
                    for (int bj = 0; bj < 2; ++bj)
#pragma unroll
                        for (int n = 0; n < 2; ++n) { const f32x4 v = acc[ai][bj][m][n]; ss += (v[0] * v[0] + v[1] * v[1]) + (v[2] * v[2] + v[3] * v[3]); }
                    ss += __shfl_xor(ss, 16); ss += __shfl_xor(ss, 32);
                    const float r = 1.0f / sqrtf(ss * (1.f / 64.f) + EPS);
                    bf16* rowp = dst + (size_t)(rowb + ai * 128 + m * 16) * ld + cw;
#pragma unroll
                    for (int bj = 0; bj < 2; ++bj) { const f32x4 v0 = acc[ai][bj][m][0] * r * g[bj][0], v1 = acc[ai][bj][m][1] * r * g[bj][1];
                        u32x4 w; w.x = pk2(v0[0], v0[1]); w.y = pk2(v0[2], v0[3]); w.z = pk2(v1[0], v1[1]); w.w = pk2(v1[2], v1[3]);
                        *(u32x4*)(rowp + 32 * bj) = w; }
                }
        } else if (pn == 46) {
            if (wc == 0 && fq < 2) {
#pragma unroll
                for (int ai = 0; ai < 2; ++ai)
#pragma unroll
                    for (int m = 0; m < 4; ++m) { float* rowp = GLR + (size_t)(rowb + ai * 128 + m * 16) * 16 + 8 * fq;
                        *(f32x4*)(rowp) = acc[ai][0][m][0]; *(f32x4*)(rowp + 4) = acc[ai][0][m][1]; }
            }
        } else {
            bf16* dst; int ld; int act;
            if (pn == 5)       { dst = AV; ld = 256; act = 0; }
            else if (pn < 10)  { dst = GQ + (pn - 6) * 256;  ld = 1024; act = 1; }
            else if (pn < 14)  { dst = GK + (pn - 10) * 256; ld = 1024; act = 0; }
            else if (pn < 22)  { dst = GV + (pn - 14) * 256; ld = 2048; act = 0; }
            else if (pn < 30)  { dst = GR + (pn - 22) * 256; ld = 2048; act = 2; }
            else {
                unsigned char* d8 = (pn < 38) ? GA + (pn - 30) * 256 : GB + (pn - 38) * 256;
#pragma unroll
                for (int ai = 0; ai < 2; ++ai)
#pragma unroll
                    for (int m = 0; m < 4; ++m) { unsigned char* rowp = d8 + (size_t)(rowb + ai * 128 + m * 16) * 2048 + cw;
#pragma unroll
                        for (int bj = 0; bj < 2; ++bj) { unsigned q[8];
#pragma unroll
                            for (int e = 0; e < 4; ++e) { q[e] = (unsigned)fmaxf(1.0f, rintf(255.0f * sigmoidf_(acc[ai][bj][m][0][e]))); q[4 + e] = (unsigned)fmaxf(1.0f, rintf(255.0f * sigmoidf_(acc[ai][bj][m][1][e]))); }
                            u32x2 w; w.x = q[0] | (q[1] << 8) | (q[2] << 16) | (q[3] << 24); w.y = q[4] | (q[5] << 8) | (q[6] << 16) | (q[7] << 24);
                            *(u32x2*)(rowp + 32 * bj) = w; } }
                return; }
#pragma unroll
            for (int ai = 0; ai < 2; ++ai)
#pragma unroll
                for (int m = 0; m < 4; ++m) { bf16* rowp = dst + (size_t)(rowb + ai * 128 + m * 16) * ld + cw;
#pragma unroll
                    for (int bj = 0; bj < 2; ++bj) { f32x4 v0 = acc[ai][bj][m][0], v1 = acc[ai][bj][m][1];
                        if (act == 1) { v0 = v0 * 0.0625f; v1 = v1 * 0.0625f; }
                        else if (act >= 2) {
#pragma unroll
                            for (int e = 0; e < 4; ++e) { const float s0 = sigmoidf_(v0[e]), s1 = sigmoidf_(v1[e]); v0[e] = (act == 2) ? v0[e] * s0 : s0; v1[e] = (act == 2) ? v1[e] * s1 : s1; } }
                        u32x4 w; w.x = pk2(v0[0], v0[1]); w.y = pk2(v0[2], v0[3]); w.z = pk2(v1[0], v1[1]); w.w = pk2(v1[2], v1[3]);
                        *(u32x4*)(rowp + 32 * bj) = w; } }
        }
    }
};
template <int MODE  > struct EpiBf16Gate {
    static constexpr bool PERM = true; static constexpr bool ROWP = false;
    bf16* O; int ldc; const bf16* G; const bf16* ADD;
    __device__ __forceinline__ void operator()(const f32x4 (&acc)[2][2][4][2], const Unit& u, int wr, int wc, int fr, int fq) const {
        const int rowb = u.pm * 256 + wr * 64 + fr; const int col0 = u.pn * 256 + 64 * wc + 8 * fq;
#pragma unroll
        for (int ai = 0; ai < 2; ++ai)
#pragma unroll
            for (int m = 0; m < 4; ++m) { const size_t ro = (size_t)(rowb + ai * 128 + m * 16) * ldc + col0;
#pragma unroll
                for (int bj = 0; bj < 2; ++bj) { float v[8];
#pragma unroll
                    for (int e = 0; e < 4; ++e) { v[e] = acc[ai][bj][m][0][e]; v[4 + e] = acc[ai][bj][m][1][e]; }
                    if (MODE >= 1) { float gg[8]; unpack8(*(const u32x4*)(G + ro + 32 * bj), gg);
#pragma unroll
                        for (int e = 0; e < 8; ++e) v[e] *= gg[e]; }
                    if (MODE == 2) { float aa[8]; unpack8(*(const u32x4*)(ADD + ro + 32 * bj), aa);
#pragma unroll
                        for (int e = 0; e < 8; ++e) v[e] += aa[e]; }
                    u32x4 w; w.x = pk2(v[0], v[1]); w.y = pk2(v[2], v[3]); w.z = pk2(v[4], v[5]); w.w = pk2(v[6], v[7]);
                    *(u32x4*)(O + ro + 32 * bj) = w; } }
    }
};
struct EpiRes {
    static constexpr bool PERM = false; static constexpr bool ROWP = false;
    const float* base; float* out; const float* gate; int row_base;
    __device__ __forceinline__ void operator()(const f32x4 (&acc)[2][2][4][2], const Unit& u, int wr, int wc, int fr, int fq) const {
        const int rowb = u.pm * 256 + wr * 64 + fr; const int col0 = u.pn * 256 + 64 * wc + 4 * fq;
        const int b = (row_base + u.pm * 256) >> 12;
        f32x4 gv[2][2];
#pragma unroll
        for (int bj = 0; bj < 2; ++bj)
#pragma unroll
            for (int n = 0; n < 2; ++n) gv[bj][n] = *(const f32x4*)(gate + (size_t)b * NMOD + col0 + 32 * bj + 16 * n);
#pragma unroll
        for (int ai = 0; ai < 2; ++ai)
#pragma unroll
            for (int m = 0; m < 4; ++m) { const size_t ro = (size_t)(rowb + ai * 128 + m * 16) * DM + col0;
#pragma unroll
                for (int bj = 0; bj < 2; ++bj)
#pragma unroll
                    for (int n = 0; n < 2; ++n) { const f32x4 bs = *(const f32x4*)(base + ro + 32 * bj + 16 * n);
                        *(f32x4*)(out + ro + 32 * bj + 16 * n) = bs + gv[bj][n] * acc[ai][bj][m][n]; } }
    }
};

struct EpiResToBf16 {
    static constexpr bool PERM = true; static constexpr bool ROWP = false;
    const float* base; bf16* out; const float* gate;
    __device__ __forceinline__ void operator()(const f32x4 (&acc)[2][2][4][2], const Unit& u, int wr, int wc, int fr, int fq) const {
        const int rowb = u.pm * 256 + wr * 64 + fr; const int col0 = u.pn * 256 + 64 * wc + 8 * fq;
        const int b = (u.pm * 256) >> 12;
        f32x4 gv[2][2];
#pragma unroll
        for (int bj = 0; bj < 2; ++bj)
#pragma unroll
            for (int n = 0; n < 2; ++n) gv[bj][n] = *(const f32x4*)(gate + (size_t)b * NMOD + col0 + 32 * bj + 4 * n);
#pragma unroll
        for (int ai = 0; ai < 2; ++ai)
#pragma unroll
            for (int m = 0; m < 4; ++m) { const size_t ro = (size_t)(rowb + ai * 128 + m * 16) * DM + col0;
#pragma unroll
                for (int bj = 0; bj < 2; ++bj) { const f32x4 b0 = *(const f32x4*)(base + ro + 32 * bj), b1 = *(const f32x4*)(base + ro + 32 * bj + 4);
                    const f32x4 v0 = b0 + gv[bj][0] * acc[ai][bj][m][0], v1 = b1 + gv[bj][1] * acc[ai][bj][m][1];
                    u32x4 w; w.x = pk2(v0[0], v0[1]); w.y = pk2(v0[2], v0[3]); w.z = pk2(v1[0], v1[1]); w.w = pk2(v1[2], v1[3]);
                    *(u32x4*)(out + ro + 32 * bj) = w; } }
    }
};
struct EpiResFromBf16 {
    static constexpr bool PERM = false; static constexpr bool ROWP = false;
    const bf16* base; float* out; const float* gate;
    __device__ __forceinline__ void operator()(const f32x4 (&acc)[2][2][4][2], const Unit& u, int wr, int wc, int fr, int fq) const {
        const int rowb = u.pm * 256 + wr * 64 + fr; const int col0 = u.pn * 256 + 64 * wc + 4 * fq;
        const int b = (u.pm * 256) >> 12;
        f32x4 gv[2][2];
#pragma unroll
        for (int bj = 0; bj < 2; ++bj)
#pragma unroll
            for (int n = 0; n < 2; ++n) gv[bj][n] = *(const f32x4*)(gate + (size_t)b * NMOD + col0 + 32 * bj + 16 * n);
#pragma unroll
        for (int ai = 0; ai < 2; ++ai)
#pragma unroll
            for (int m = 0; m < 4; ++m) { const size_t ro = (size_t)(rowb + ai * 128 + m * 16) * DM + col0;
#pragma unroll
                for (int bj = 0; bj < 2; ++bj)
#pragma unroll
                    for (int n = 0; n < 2; ++n) { const u32x2 bw = *(const u32x2*)(base + ro + 32 * bj + 16 * n);
                        const f32x4 bs = (f32x4){bf2f(bw.x & 0xffffu), bf2f(bw.x >> 16), bf2f(bw.y & 0xffffu), bf2f(bw.y >> 16)};
                        *(f32x4*)(out + ro + 32 * bj + 16 * n) = bs + gv[bj][n] * acc[ai][bj][m][n]; } }
    }
};
__device__ __forceinline__ f32x4 dpp_shr1(f32x4 old, f32x4 v) { f32x4 r;
#pragma unroll
    for (int e = 0; e < 4; ++e) r[e] = __int_as_float(__builtin_amdgcn_update_dpp(__float_as_int(old[e]), __float_as_int(v[e]), 0x111, 0xf, 0xf, false)); return r; }
struct EpiConvGate {
    static constexpr bool PERM = true; static constexpr bool ROWP = true;
    bf16* ACT; float* HALO; const float* cw; const float* cb; LAS float* xch;
    __device__ __forceinline__ void operator()(const f32x4 (&acc)[2][2][4][2], const Unit& u, int wr, int wc, int fr, int fq) const {
        const int pm = u.pm, pn = u.pn;
        if (fr == 15) {
#pragma unroll
            for (int ai = 0; ai < 2; ++ai)
#pragma unroll
                for (int bj = 0; bj < 2; ++bj)
#pragma unroll
                    for (int n = 0; n < 2; ++n) { LAS float* d = xch + (((ai * 2 + wr) * 4 + wc) * 2) * 64 + 32 * bj + 8 * fq + 4 * n;
                        *(LAS f32x4*)(d) = acc[ai][bj][2][n]; *(LAS f32x4*)(d + 64) = acc[ai][bj][3][n]; }
        }
        { const int colh = pn * 256 + 64 * wc + 8 * fq;
          if (wr == 0 && fr == 0) {
#pragma unroll
            for (int bj = 0; bj < 2; ++bj)
#pragma unroll
                for (int n = 0; n < 2; ++n) { *(f32x4*)(HALO + (size_t)(pm * 4 + 0) * NUP + colh + 32 * bj + 4 * n) = acc[0][bj][0][n]; *(f32x4*)(HALO + (size_t)(pm * 4 + 1) * NUP + colh + 32 * bj + 4 * n) = acc[0][bj][1][n]; }
          }
          if (wr == 1 && fr == 15) {
#pragma unroll
            for (int bj = 0; bj < 2; ++bj)
#pragma unroll
                for (int n = 0; n < 2; ++n) { *(f32x4*)(HALO + (size_t)(pm * 4 + 2) * NUP + colh + 32 * bj + 4 * n) = acc[1][bj][2][n]; *(f32x4*)(HALO + (size_t)(pm * 4 + 3) * NUP + colh + 32 * bj + 4 * n) = acc[1][bj][3][n]; }
          } }
        asm volatile("s_waitcnt lgkmcnt(0)" ::: "memory"); __builtin_amdgcn_s_barrier(); asm volatile("" ::: "memory");
#pragma unroll
        for (int n = 0; n < 2; ++n) {
            const int j0 = 128 * pn + 32 * wc + 8 * fq + 4 * n;
            f32x4 wa[3], wb[3];
#pragma unroll
            for (int tap = 0; tap < 3; ++tap) { wa[tap] = *(const f32x4*)(cw + (size_t)tap * NUP + j0); wb[tap] = *(const f32x4*)(cw + (size_t)tap * NUP + DFF + j0); }
            const f32x4 ba = *(const f32x4*)(cb + j0), bb = *(const f32x4*)(cb + DFF + j0);
#pragma unroll
            for (int ai = 0; ai < 2; ++ai) {
                f32x4 a62 = (f32x4){0.f, 0.f, 0.f, 0.f}, a63 = a62, b62 = a62, b63 = a62;
                if (wr == 1 || ai == 1) {
                    const int sai = (wr == 1) ? ai : ai - 1, swr = 1 - wr;
                    const LAS float* src = xch + (((sai * 2 + swr) * 4 + wc) * 2) * 64 + 8 * fq + 4 * n;
                    a62 = *(const LAS f32x4*)(src); a63 = *(const LAS f32x4*)(src + 64); b62 = *(const LAS f32x4*)(src + 32); b63 = *(const LAS f32x4*)(src + 96);
                }
                const f32x4 ua0 = acc[ai][0][0][n], ua1 = acc[ai][0][1][n], ua2 = acc[ai][0][2][n], ua3 = acc[ai][0][3][n];
                const f32x4 ub0 = acc[ai][1][0][n], ub1 = acc[ai][1][1][n], ub2 = acc[ai][1][2][n], ub3 = acc[ai][1][3][n];
                const f32x4 sa3 = dpp_shr1(a63, ua3), sa2 = dpp_shr1(a62, ua2), sb3 = dpp_shr1(b63, ub3), sb2 = dpp_shr1(b62, ub2);
                f32x4 ya[4], yb[4];
                ya[0] = ba + wa[2] * ua0 + wa[1] * sa3 + wa[0] * sa2; yb[0] = bb + wb[2] * ub0 + wb[1] * sb3 + wb[0] * sb2;
                ya[1] = ba + wa[2] * ua1 + wa[1] * ua0 + wa[0] * sa3; yb[1] = bb + wb[2] * ub1 + wb[1] * ub0 + wb[0] * sb3;
                ya[2] = ba + wa[2] * ua2 + wa[1] * ua1 + wa[0] * ua0; yb[2] = bb + wb[2] * ub2 + wb[1] * ub1 + wb[0] * ub0;
                ya[3] = ba + wa[2] * ua3 + wa[1] * ua2 + wa[0] * ua1; yb[3] = bb + wb[2] * ub3 + wb[1] * ub2 + wb[0] * ub1;
#pragma unroll
                for (int m = 0; m < 4; ++m) {
                    f32x4 r;
#pragma unroll
                    for (int e = 0; e < 4; ++e) r[e] = ya[m][e] * sigmoidf_(ya[m][e]) * yb[m][e];
                    const bool skip = (ai == 0) && (wr == 0) && (m < 2) && (fr == 0);
                    if (!skip) { u32x2 w; w.x = pk2(r[0], r[1]); w.y = pk2(r[2], r[3]);
                        *(u32x2*)(ACT + (size_t)(pm * 256 + ai * 128 + wr * 64 + 4 * fr + m) * DFF + j0) = w; }
                }
            }
        }
    }
};

struct EpiMerge {
    static constexpr bool PERM = true; static constexpr bool ROWP = false;
    bf16* O; const unsigned char* GA; const unsigned char* GB;
    __device__ __forceinline__ void mid(f32x4 (&acc)[2][2][4][2], const Unit& u, int wr, int wc, int fr, int fq) const {
        const int rowb = u.pm * 256 + wr * 64 + fr; const int col0 = u.pn * 256 + 64 * wc + 8 * fq;
#pragma unroll
        for (int ai = 0; ai < 2; ++ai)
#pragma unroll
            for (int m = 0; m < 4; ++m) { const size_t ro = (size_t)(rowb + ai * 128 + m * 16) * DM + col0;
#pragma unroll
                for (int bj = 0; bj < 2; ++bj) { float ga[8], gb[8]; unpack8u(*(const u32x2*)(GA + ro + 32 * bj), ga); unpack8u(*(const u32x2*)(GB + ro + 32 * bj), gb);
#pragma unroll
                    for (int e = 0; e < 4; ++e) { acc[ai][bj][m][0][e] *= ga[e] * __builtin_amdgcn_rcpf(gb[e]); acc[ai][bj][m][1][e] *= ga[4 + e] * __builtin_amdgcn_rcpf(gb[4 + e]); } } }
    }
    __device__ __forceinline__ void operator()(const f32x4 (&acc)[2][2][4][2], const Unit& u, int wr, int wc, int fr, int fq) const {
        const int rowb = u.pm * 256 + wr * 64 + fr; const int col0 = u.pn * 256 + 64 * wc + 8 * fq;
#pragma unroll
        for (int ai = 0; ai < 2; ++ai)
#pragma unroll
            for (int m = 0; m < 4; ++m) { const size_t ro = (size_t)(rowb + ai * 128 + m * 16) * DM + col0;
#pragma unroll
                for (int bj = 0; bj < 2; ++bj) { float gb[8]; unpack8u(*(const u32x2*)(GB + ro + 32 * bj), gb); float v[8];
#pragma unroll
                    for (int e = 0; e < 4; ++e) { v[e] = acc[ai][bj][m][0][e] * gb[e]; v[4 + e] = acc[ai][bj][m][1][e] * gb[4 + e]; }
                    u32x4 w; w.x = pk2(v[0], v[1]); w.y = pk2(v[2], v[3]); w.z = pk2(v[4], v[5]); w.w = pk2(v[6], v[7]);
                    *(u32x4*)(O + ro + 32 * bj) = w; } }
    }
};
template <int MAP  > __device__ __forceinline__ int dst_row(int n) {
    if (MAP == 1) { return n < 7680 ? n : (n < 7696 ? n + 4096 : n - 16); }
    if (MAP == 2) { const int half = n >= DFF ? 1 : 0, j = n - half * DFF; return 256 * (j >> 7) + 64 * ((j >> 5) & 3) + 32 * half + (j & 31); }
    return n;
}
template <int MAP> __device__ __forceinline__ void transpose_item(const float* W, int K, int N, bf16* WT, LAS float* scr, int item, int lane) {
    const int nblk = (N + 31) / 32, kb = item / nblk, nb = item % nblk, k0 = 64 * kb, n0 = 32 * nb;
    const int nn = n0 + (lane & 31); const bool ok = nn < N;
    float v[32];
    const float* wp = W + (size_t)(k0 + (lane >> 5)) * N + nn;
#pragma unroll
    for (int i = 0; i < 32; ++i) v[i] = ok ? wp[(size_t)(2 * i) * N] : 0.f;
#pragma unroll
    for (int i = 0; i < 32; ++i) scr[(2 * i + (lane >> 5)) * 33 + (lane & 31)] = v[i];
    asm volatile("s_waitcnt lgkmcnt(0)" ::: "memory");
    const int c = lane & 7;
#pragma unroll
    for (int j = 0; j < 4; ++j) { const int n = (lane >> 3) + 8 * j; const LAS float* s = scr + (8 * c) * 33 + n;
        u32x4 o; o.x = pk2(s[0 * 33], s[1 * 33]); o.y = pk2(s[2 * 33], s[3 * 33]); o.z = pk2(s[4 * 33], s[5 * 33]); o.w = pk2(s[6 * 33], s[7 * 33]);
        if (n0 + n < N) *(u32x4*)(WT + (size_t)dst_row<MAP>(n0 + n) * K + k0 + 8 * c) = o; }
    asm volatile("s_waitcnt lgkmcnt(0)" ::: "memory");
}

#define GAS __attribute__((address_space(1)))
#define XB_TMO      128
#define XB_XCNT(j)  (256  + 64 * (j))
#define XB_XSUB(j)  (1280 + 64 * (j))
#define XB_XGEN(j)  (2304 + 64 * (j))
#define XB_TOP      3328
#define XB_TOPGEN   3392
#define XCD_BAR_WORDS 3456
#define XB_SPIN_CAP (1u << 18)
__device__ __forceinline__ unsigned xb_ld(unsigned* p)              { return __hip_atomic_load(p, __ATOMIC_RELAXED, __HIP_MEMORY_SCOPE_AGENT); }
__device__ __forceinline__ unsigned xb_add(unsigned* p, unsigned v) { return __hip_atomic_fetch_add(p, v, __ATOMIC_RELAXED, __HIP_MEMORY_SCOPE_AGENT); }
__device__ __forceinline__ unsigned xb_xcc_id() { return (unsigned)__builtin_amdgcn_s_getreg((3 << 11) | 20) & 0xFu; }
#define XB_SPIN(cond, bar) do { unsigned _sp = 0; while (cond) { __builtin_amdgcn_s_sleep(1); \
    if ((++_sp & 255u) == 0u) { if (xb_ld(&(bar)[XB_TMO])) break; if (_sp > XB_SPIN_CAP) { atomicAdd(&(bar)[XB_TMO], 1u); break; } } } } while (0)
struct XcdBarrier { unsigned* bar; unsigned x; volatile LAS unsigned* st; };
__device__ __forceinline__ XcdBarrier xcd_barrier_post(unsigned* bar, volatile LAS unsigned* st) {
    XcdBarrier b; b.bar = bar; b.x = xb_xcc_id(); b.st = st;
    if (threadIdx.x == 0) (void)xb_add(&bar[XB_XCNT(b.x)], 1u);
    return b;
}
__device__ __forceinline__ void xcd_barrier_complete(unsigned* bar, unsigned x, unsigned& nloc, unsigned& nx) {
    const unsigned G = gridDim.x * gridDim.y * gridDim.z;
    unsigned sum, cnt, mine, sp = 0u;
    for (;;) {
        sum = 0u; cnt = 0u; mine = 0u;
#pragma unroll
        for (unsigned j = 0; j < 16; ++j) { const unsigned c = xb_ld(&bar[XB_XCNT(j)]); sum += c; cnt += (c > 0u) ? 1u : 0u; mine = (j == x) ? c : mine; }
        if (sum == G) break;
        __builtin_amdgcn_s_sleep(1);
        if ((++sp & 255u) == 0u) { if (xb_ld(&bar[XB_TMO])) break; if (sp > XB_SPIN_CAP) { atomicAdd(&bar[XB_TMO], 1u); break; } }
    }
    nloc = mine > 0u ? mine : 1u; nx = cnt > 0u ? cnt : 1u;
}
__device__ __forceinline__ void xcd_barrier(const XcdBarrier& b) {
    asm volatile("s_waitcnt vmcnt(0)" ::: "memory");
    __syncthreads();
    if (threadIdx.x == 0) {
        unsigned* bar = b.bar;
        __builtin_amdgcn_s_waitcnt(0);
        unsigned nloc = b.st[0], nx = b.st[1];
        if (nloc == 0u) { xcd_barrier_complete(bar, b.x, nloc, nx); b.st[0] = nloc; b.st[1] = nx; }
        const unsigned old = xb_add(&bar[XB_XSUB(b.x)], 1u);
        const unsigned gen = old / nloc;
        if (old + 1u == (gen + 1u) * nloc) {
            __builtin_amdgcn_fence(__ATOMIC_RELEASE, "agent");
            asm volatile("s_waitcnt vmcnt(0)" ::: "memory");
            const unsigned og = xb_add(&bar[XB_TOP], 1u);
            const unsigned tg = og / nx;
            if (og + 1u == (tg + 1u) * nx) xb_add(&bar[XB_TOPGEN], 1u);
            else XB_SPIN(xb_ld(&bar[XB_TOPGEN]) == tg, bar);
            __builtin_amdgcn_fence(__ATOMIC_ACQUIRE, "agent");
            xb_add(&bar[XB_XGEN(b.x)], 1u);
            asm volatile("s_waitcnt vmcnt(0)" ::: "memory");
        } else {
            XB_SPIN(xb_ld(&bar[XB_XGEN(b.x)]) == gen, bar);
            __builtin_amdgcn_fence(__ATOMIC_ACQUIRE, "agent");
            asm volatile("s_waitcnt vmcnt(0)" ::: "memory");
        }
    }
    __syncthreads();
}

struct Args {
    const float* in[21]; float* out; unsigned char* ws; int ph_lo, ph_hi;
};

__global__ void __launch_bounds__(NT_BLK, 2) fwd_kernel(Args a) {
    extern __shared__ __attribute__((aligned(16))) unsigned char lds_raw[];
    LAS unsigned char* lds = (LAS unsigned char*)lds_raw;
    volatile LAS unsigned* bst = (volatile LAS unsigned*)((LAS unsigned char*)lds_raw + (LDS_BYTES - 16));
    if (threadIdx.x < 2) bst[threadIdx.x] = 0u;
    __syncthreads();
    XcdBarrier xbar = xcd_barrier_post((unsigned*)a.ws, bst);
    const int tid = threadIdx.x, lane = tid & 63, wave = __builtin_amdgcn_readfirstlane(tid >> 6);
    const int G = gridDim.x, bx = blockIdx.x;
    const int gw = bx * NWAVES + wave, NGW = G * NWAVES;
    unsigned char* ws = a.ws;
    const float* x = a.in[0]; const float* cvec = a.in[1]; const float* relb = a.in[2]; const float* w_ada = a.in[3]; const float* b_ada = a.in[4];
    const float* g1 = a.in[5]; const float* w_in = a.in[6]; const float* qg = a.in[7]; const float* kg = a.in[8]; const float* sinks = a.in[9];
    const float* wgk = a.in[10]; const float* bgk = a.in[11]; const float* glag = a.in[12]; const float* wba = a.in[13]; const float* wbg = a.in[14];
    const float* wout = a.in[15]; const float* g2 = a.in[16]; const float* wup = a.in[17]; const float* convw = a.in[18]; const float* convb = a.in[19]; const float* wdn = a.in[20];
    float* out = a.out;
    float* MODP = (float*)(ws + WS_MODP2); float* MODF = (float*)(ws + WS_MODF);
    bf16* WIN_T = (bf16*)(ws + WS_WIN); bf16* WBA_T = (bf16*)(ws + WS_WBA); bf16* WBG_T = (bf16*)(ws + WS_WBG); bf16* WOUT_T = (bf16*)(ws + WS_WOUT);
    bf16* WUP_T = (bf16*)(ws + WS_WUP); bf16* WDN_T = (bf16*)(ws + WS_WDN);
    bf16* XN = (bf16*)(ws + WS_XN); bf16* OB = (bf16*)(ws + WS_O); bf16* YATT = (bf16*)(ws + WS_YATT);
    float* GLR = (float*)(ws + WS_GLR);
    bf16* AMg = (bf16*)(ws + WS_AM); float* DECg = (float*)(ws + WS_DEC); bf16* QDg = (bf16*)(ws + WS_QD); bf16* KTETg = (bf16*)(ws + WS_KTET);
    bf16* AQ = (bf16*)(ws + WS_AQ); bf16* AK = (bf16*)(ws + WS_AK); bf16* AV = (bf16*)(ws + WS_AV); bf16* GQ = (bf16*)(ws + WS_GQ); bf16* GK = (bf16*)(ws + WS_GK);
    bf16* GV = (bf16*)(ws + WS_GV); bf16* GR = (bf16*)(ws + WS_GR); unsigned char* GA = (unsigned char*)out; unsigned char* GB = GA + (size_t)M * DM;
    bf16* X1B = (bf16*)(ws + WS_X1B); bf16* M1 = (bf16*)(ws + WS_M1); bf16* MRG = (bf16*)(ws + WS_MRG); bf16* ACT = (bf16*)(ws + WS_ACT); float* HALO = (float*)(ws + WS_HALO);
    const int lo = a.ph_lo, hi = a.ph_hi;
#ifndef DUP_MASK
#define DUP_MASK 0x0u
#endif
#define REP(k) _Pragma("unroll") for (int rep_ = 0; rep_ <= (int)((DUP_MASK >> (k)) & 1u); ++rep_)
#ifndef PH_MASK
#define PH_MASK 0xFFFFFFFFu
#endif
#define IN(k) (lo <= (k) && (k) < hi && ((PH_MASK >> (k)) & 1u))
#define SEAM(k) do { if (IN(k) && IN((k) + 1)) xcd_barrier(xbar); } while (0)

    if (IN(0)) REP(0) {
        for (int item = gw; item < ADA_KS * 48; item += NGW) {
            const int ks = item / 48, ng = item % 48, n0 = ng * 256 + lane * 4, k0 = ks * 64;
            f32x4 ac[4] = {{0.f, 0.f, 0.f, 0.f}, {0.f, 0.f, 0.f, 0.f}, {0.f, 0.f, 0.f, 0.f}, {0.f, 0.f, 0.f, 0.f}};
#pragma unroll 8
            for (int kk = 0; kk < 64; ++kk) { const int k = k0 + kk; const f32x4 w = *(const f32x4*)(w_ada + (size_t)k * NMOD + n0);
#pragma unroll
                for (int b = 0; b < 4; ++b) { const float cv = cvec[b * DM + k]; const float cs = cv * sigmoidf_(cv); ac[b] += w * cs; } }
#pragma unroll
            for (int b = 0; b < 4; ++b) *(f32x4*)(MODP + ((size_t)(ks * 4 + b)) * NMOD + n0) = ac[b];
        }
        LAS float* scr = (LAS float*)(lds + wave * 16384);
        constexpr int I_IN = 32 * 369, I_BA = 16 * 64, I_BG = 32 * 64, I_OUT = 32 * 64, I_DN = 88 * 64;
        for (int it = gw; it < I_IN + I_BA + I_BG + I_OUT + I_DN; it += NGW) {
            int r = it;
            if (r < I_IN) { transpose_item<1>(w_in, DM, D_IN, WIN_T, scr, r, lane); continue; } r -= I_IN;
            if (r < I_BA) { transpose_item<0>(wba, 1024, DM, WBA_T, scr, r, lane); continue; } r -= I_BA;
            if (r < I_BG) { transpose_item<0>(wbg, DM, DM, WBG_T, scr, r, lane); continue; } r -= I_BG;
            if (r < I_OUT) { transpose_item<0>(wout, DM, DM, WOUT_T, scr, r, lane); continue; } r -= I_OUT;
            transpose_item<0>(wdn, DFF, DM, WDN_T, scr, r, lane);
        }
        for (int i = bx * NT_BLK + tid; i < 240 * 256; i += G * NT_BLK) ((u32x4*)(WIN_T + (size_t)11792 * DM))[i] = (u32x4){0u, 0u, 0u, 0u};
    }
    SEAM(0);

    if (IN(1)) REP(1) {
        { const int per = (4 * NMOD) / G; for (int i = tid; i < per; i += NT_BLK) { const int idx = bx * per + i; const int b = idx / NMOD, n = idx % NMOD; float s = b_ada[n];
#pragma unroll
            for (int ks = 0; ks < ADA_KS; ++ks) s += MODP[((size_t)(ks * 4 + b)) * NMOD + n];
            MODF[idx] = s; } }
        LAS float* sA = (LAS float*)lds; LAS float* sB = sA + DM;
        const int rows_per = M / G; const int b = (bx * rows_per) >> 12;
        for (int k = 4 * tid; k < DM; k += 4 * NT_BLK) { f32x4 sh = *(const f32x4*)(b_ada + k), sc = *(const f32x4*)(b_ada + DM + k);
#pragma unroll 16
            for (int ks = 0; ks < ADA_KS; ++ks) { sh += *(const f32x4*)(MODP + ((size_t)(ks * 4 + b)) * NMOD + k); sc += *(const f32x4*)(MODP + ((size_t)(ks * 4 + b)) * NMOD + DM + k); }
            *(LAS f32x4*)(sA + k) = *(const f32x4*)(g1 + k) * (1.f + sc); *(LAS f32x4*)(sB + k) = sh; }
        __syncthreads();
        for (int r = wave; r < rows_per; r += 2 * NWAVES) {
            const size_t row0 = (size_t)bx * rows_per + r, row1 = row0 + NWAVES;
            const f32x4* xr0 = (const f32x4*)(x + row0 * DM) + lane; const f32x4* xr1 = (const f32x4*)(x + row1 * DM) + lane; f32x4 v0[8], v1[8];
#pragma unroll
            for (int j = 0; j < 8; ++j) { v0[j] = xr0[64 * j]; v1[j] = xr1[64 * j]; }
            float ss0 = 0.f, ss1 = 0.f;
#pragma unroll
            for (int j = 0; j < 8; ++j) { ss0 += (v0[j][0] * v0[j][0] + v0[j][1] * v0[j][1]) + (v0[j][2] * v0[j][2] + v0[j][3] * v0[j][3]);
                                          ss1 += (v1[j][0] * v1[j][0] + v1[j][1] * v1[j][1]) + (v1[j][2] * v1[j][2] + v1[j][3] * v1[j][3]); }
            const float rstd0 = 1.0f / sqrtf(wave_sum(ss0) * (1.f / DM) + EPS), rstd1 = 1.0f / sqrtf(wave_sum(ss1) * (1.f / DM) + EPS);
            u32x2* o80 = (u32x2*)(XN + row0 * DM) + lane; u32x2* o81 = (u32x2*)(XN + row1 * DM) + lane;
#pragma unroll
            for (int j = 0; j < 8; ++j) { const int k = 4 * lane + 256 * j; const f32x4 A4 = *(const LAS f32x4*)(sA + k), B4 = *(const LAS f32x4*)(sB + k);
                const f32x4 h0 = v0[j] * rstd0 * A4 + B4, h1 = v1[j] * rstd1 * A4 + B4;
                u32x2 w0, w1; w0.x = pk2(h0[0], h0[1]); w0.y = pk2(h0[2], h0[3]); w1.x = pk2(h1[0], h1[1]); w1.y = pk2(h1[2], h1[3]); o80[64 * j] = w0; o81[64 * j] = w1; }
        }
        __syncthreads();
    }
    SEAM(1);

    if (IN(2)) REP(2) {
        pg8::Gemm g{XN, WIN_T, M, NIN_PAD, DM}; pg8::StaticOrder S; S.init(M, NIN_PAD, G, bx, P2_WGM);
        EpiInProj E{AQ, AK, AV, GQ, GK, GV, GR, GA, GB, GLR, qg, kg};
        { const int nlong = ((M / 256) * (NIN_PAD / 256)) % G; const int nshort = G - nlong;
          if (nlong > 0 && bx >= nlong) { LAS float* scr = (LAS float*)(lds + wave * 16384); constexpr int I_UP = 32 * 352;
              for (int it = (bx - nlong) * NWAVES + wave; it < I_UP; it += nshort * NWAVES) transpose_item<2>(wup, DM, NUP, WUP_T, scr, it, lane); }
          else if (nlong == 0) { LAS float* scr = (LAS float*)(lds + wave * 16384); constexpr int I_UP = 32 * 352;
              for (int it = gw; it < I_UP; it += NGW) transpose_item<2>(wup, DM, NUP, WUP_T, scr, it, lane); } }
            __syncthreads();
        pg8::gemm_phase<EpiInProj, pg8::StaticOrder, true, PG8_SP2V>(lds, g, S, E);
    }
    SEAM(2);

    if (IN(3)) REP(3) {
        typedef short bf16x8 __attribute__((ext_vector_type(8)));
        LAS bf16* Ks = (LAS bf16*)lds;
        LAS bf16* VT = Ks + 256 * 72;
        LAS float* blut = (LAS float*)(VT + 64 * 264);
        const int l15 = lane & 15, l4 = lane >> 4;
        REP(13) for (int unit = bx; unit < 512; unit += G) {
            const int nb = unit & 31, hk = (unit >> 5) & 3, b = unit >> 7;
            const long tokb = (long)b * SEQ + nb * 128 - 128;
            const int gq = wave >> 1, hq = 4 * hk + gq; const float sink = sinks[hq];
            bf16x8 qf[4][2];
#pragma unroll
            for (int i = 0; i < 4; ++i) { const size_t tq = (size_t)b * SEQ + nb * 128 + 64 * (wave & 1) + 16 * i + l15;
                qf[i][0] = *(const bf16x8*)(AQ + tq * 1024 + hq * 64 + 8 * l4); qf[i][1] = *(const bf16x8*)(AQ + tq * 1024 + hq * 64 + 32 + 8 * l4); }
            __syncthreads();
#pragma unroll
            for (int i = 0; i < 4; ++i) { const int p = tid + 512 * i, key = p >> 3, ch = p & 7; const bool ok = (nb > 0) || (key >= 128);
                u32x4 kv = (u32x4){0u, 0u, 0u, 0u}, vv = (u32x4){0u, 0u, 0u, 0u};
                if (ok) { kv = *(const u32x4*)(AK + (size_t)(tokb + key) * 256 + hk * 64 + ch * 8); vv = *(const u32x4*)(AV + (size_t)(tokb + key) * 256 + hk * 64 + ch * 8); }
                *(LAS u32x4*)(Ks + key * 72 + ch * 8) = kv;
                LAS bf16* vt = VT + (ch * 8) * 264 + key;
                vt[0 * 264] = (bf16)(vv.x & 0xffffu); vt[1 * 264] = (bf16)(vv.x >> 16); vt[2 * 264] = (bf16)(vv.y & 0xffffu); vt[3 * 264] = (bf16)(vv.y >> 16);
                vt[4 * 264] = (bf16)(vv.z & 0xffffu); vt[5 * 264] = (bf16)(vv.z >> 16); vt[6 * 264] = (bf16)(vv.w & 0xffffu); vt[7 * 264] = (bf16)(vv.w >> 16); }
            { const int gq = tid >> 7, d = tid & 127; int bk;
              if (d < 16) bk = d; else { const float v = logf((float)d / 16.0f) / 2.0794415416798357f * 16.0f; bk = 16 + (int)v; if (bk > 31) bk = 31; }
              blut[tid] = relb[bk * 16 + 4 * hk + gq]; }
            __syncthreads();
            f32x4 bv[9];
#pragma unroll
            for (int t = 0; t < 9; ++t)
#pragma unroll
                for (int r = 0; r < 4; ++r) { const int dist = l15 - 4 * l4 - r + 128 - 16 * t; bv[t][r] = (dist >= 0 && dist < 128) ? blut[gq * 128 + (dist & 127)] : -1e30f; }
#pragma unroll 1
            for (int i = 0; i < 4; ++i) {
                const int q0 = 64 * (wave & 1) + 16 * i, kt0 = q0 >> 4, iq = q0 + l15;
                const size_t tokq = (size_t)b * SEQ + nb * 128 + iq;
                const bf16x8 qf0 = qf[0][0], qf1 = qf[0][1];
                qf[0][0] = qf[1][0]; qf[0][1] = qf[1][1]; qf[1][0] = qf[2][0]; qf[1][1] = qf[2][1]; qf[2][0] = qf[3][0]; qf[2][1] = qf[3][1];
                f32x4 sc[9];
#pragma unroll
                for (int t = 0; t < 9; ++t) { const LAS bf16* kp = Ks + (16 * (kt0 + t) + l15) * 72 + 8 * l4;
                    const bf16x8 a0 = *(const LAS bf16x8*)kp, a1 = *(const LAS bf16x8*)(kp + 32);
                    f32x4 z = (f32x4){0.f, 0.f, 0.f, 0.f};
                    z = __builtin_amdgcn_mfma_f32_16x16x32_bf16(a0, qf0, z, 0, 0, 0); sc[t] = __builtin_amdgcn_mfma_f32_16x16x32_bf16(a1, qf1, z, 0, 0, 0); }
                float mx = sink;
#pragma unroll
                for (int t = 0; t < 9; ++t) { const float pen = (nb == 0 && kt0 + t < 8) ? -1e30f : 0.f;
#pragma unroll
                    for (int r = 0; r < 4; ++r) { const float s = sc[t][r] + bv[t][r] + pen; sc[t][r] = s; mx = fmaxf(mx, s); } }
                mx = fmaxf(mx, __shfl_xor(mx, 16)); mx = fmaxf(mx, __shfl_xor(mx, 32));
                float sum = 0.f;
#pragma unroll
                for (int t = 0; t < 9; ++t)
#pragma unroll
                    for (int r = 0; r < 4; ++r) { const float p = __expf(sc[t][r] - mx); sc[t][r] = p; sum += p; }
                sum += __shfl_xor(sum, 16); sum += __shfl_xor(sum, 32);
                const float inv = 1.0f / (sum + __expf(sink - mx));
                f32x4 o[4];
#pragma unroll
                for (int dt = 0; dt < 4; ++dt) o[dt] = (f32x4){0.f, 0.f, 0.f, 0.f};
#pragma unroll
                for (int ks = 0; ks < 5; ++ks) { const int ta = 2 * ks, tb = (2 * ks + 1 < 9) ? 2 * ks + 1 : 2 * ks;
                    u32x4 pw; pw.x = pk2(sc[ta][0], sc[ta][1]); pw.y = pk2(sc[ta][2], sc[ta][3]);
                    if (2 * ks + 1 < 9) { pw.z = pk2(sc[tb][0], sc[tb][1]); pw.w = pk2(sc[tb][2], sc[tb][3]); } else { pw.z = 0u; pw.w = 0u; }
                    const bf16x8 pop = __builtin_bit_cast(bf16x8, pw);
#pragma unroll
                    for (int dt = 0; dt < 4; ++dt) { const LAS bf16* vp = VT + (16 * dt + l15) * 264 + 4 * l4;
                        const u32x2 va = *(const LAS u32x2*)(vp + 16 * (kt0 + ta)), vb = *(const LAS u32x2*)(vp + 16 * (kt0 + tb));
                        const u32x4 vw = (u32x4){va.x, va.y, vb.x, vb.y};
                        o[dt] = __builtin_amdgcn_mfma_f32_16x16x32_bf16(__builtin_bit_cast(bf16x8, vw), pop, o[dt], 0, 0, 0); } }
                bf16* op = YATT + tokq * 1024 + hq * 64 + 4 * l4;
#pragma unroll
                for (int dt = 0; dt < 4; ++dt) { u32x2 w; w.x = pk2(o[dt][0] * inv, o[dt][1] * inv); w.y = pk2(o[dt][2] * inv, o[dt][3] * inv); *(u32x2*)(op + 16 * dt) = w; }
            }
        }
        __syncthreads();
        {
            typedef short bf16x8 __attribute__((ext_vector_type(8)));
            LAS float* glrs = (LAS float*)lds;
            LAS float* tots = glrs + 1024;
            LAS float* Gs = tots + 512 + 256;
            LAS bf16* QDs = (LAS bf16*)(Gs + 64 * 256);
            LAS bf16* KIs = QDs + 64 * 264;
            const int dk = tid & 255, half = tid >> 8, l15 = lane & 15, l4 = lane >> 4, cg8 = (tid & 31) * 8, r0 = tid >> 5;
            REP(14) for (int u = bx; u < 1024; u += G) {
                const int pair = u >> 6, n = u & 63, b = pair >> 2, h = pair & 3; const size_t tokc = (size_t)b * SEQ + n * 64;
                __syncthreads();
                u32x4 q8[4], k8[4];
#pragma unroll
                for (int i = 0; i < 4; ++i) { const size_t go = (tokc + r0 + 16 * i) * 1024 + h * 256 + cg8; q8[i] = *(const u32x4*)(GQ + go); k8[i] = *(const u32x4*)(GK + go); }
                glrs[tid] = GLR[tokc * 16 + tid]; glrs[tid + 512] = GLR[tokc * 16 + 512 + tid];
                float wg[16];
#pragma unroll
                for (int r = 0; r < 16; ++r) wg[r] = wgk[r * 1024 + h * 256 + dk];
                const float bg = bgk[h * 256 + dk];
                __syncthreads();
                float gl[32]; float run = 0.f;
#pragma unroll
                for (int i = 0; i < 32; ++i) { const LAS f32x4* gp = (const LAS f32x4*)(glrs + (half * 32 + i) * 16); float z = bg;
#pragma unroll
                    for (int r4 = 0; r4 < 4; ++r4) { const f32x4 gg = gp[r4]; z += gg[0] * wg[4 * r4] + gg[1] * wg[4 * r4 + 1] + gg[2] * wg[4 * r4 + 2] + gg[3] * wg[4 * r4 + 3]; }
                    const float ls = fminf(z, 0.f) - __logf(1.0f + __expf(-fabsf(z))); run += ls * 0.0625f; gl[i] = run; }
                tots[half * 256 + dk] = run;
                __syncthreads();
                const float t0 = tots[dk], t1 = tots[256 + dk]; const float glast = t0 + t1, off = half ? t0 : 0.f;
#pragma unroll
                for (int i = 0; i < 32; ++i) Gs[(half * 32 + i) * 256 + dk] = gl[i] + off;
                const float eglast = __expf(glast);
                if (half == 0) DECg[(size_t)u * 256 + dk] = eglast;
                __syncthreads();
#pragma unroll
                for (int i = 0; i < 4; ++i) { const int row = r0 + 16 * i; const f32x4 ga = *(const LAS f32x4*)(Gs + row * 256 + cg8), gb = *(const LAS f32x4*)(Gs + row * 256 + cg8 + 4);
                    float qf[8], kf[8]; unpack8(q8[i], qf); unpack8(k8[i], kf); float qd[8], ki[8];
#pragma unroll
                    for (int e = 0; e < 4; ++e) { qd[e] = qf[e] * __expf(ga[e]); ki[e] = kf[e] * __expf(-ga[e]); qd[4 + e] = qf[4 + e] * __expf(gb[e]); ki[4 + e] = kf[4 + e] * __expf(-gb[e]); }
                    u32x4 qw, kw; qw.x = pk2(qd[0], qd[1]); qw.y = pk2(qd[2], qd[3]); qw.z = pk2(qd[4], qd[5]); qw.w = pk2(qd[6], qd[7]);
                    kw.x = pk2(ki[0], ki[1]); kw.y = pk2(ki[2], ki[3]); kw.z = pk2(ki[4], ki[5]); kw.w = pk2(ki[6], ki[7]);
                    *(LAS u32x4*)(QDs + row * 264 + cg8) = qw; *(LAS u32x4*)(KIs + row * 264 + cg8) = kw;
                    *(u32x4*)(QDg + ((size_t)u * 64 + row) * 256 + cg8) = qw; }
                __syncthreads();
                {
                    unsigned ktp[16];
#pragma unroll
                    for (int i = 0; i < 32; ++i) { const float kte = bf2f(KIs[(half * 32 + i) * 264 + dk]) * eglast;
                        if (i & 1) ktp[i >> 1] |= f2bf(kte) << 16; else ktp[i >> 1] = f2bf(kte); }
                    bf16* ktdst = KTETg + (size_t)u * 16384 + (size_t)((dk >> 5) * 8 + 4 * half) * 256 + (dk & 31) * 8;
#pragma unroll
                    for (int j = 0; j < 4; ++j) *(u32x4*)(ktdst + 256 * j) = (u32x4){ktp[4 * j], ktp[4 * j + 1], ktp[4 * j + 2], ktp[4 * j + 3]};
                }
                const int ti = wave >> 1;
#pragma unroll
                for (int tjj = 0; tjj < 2; ++tjj) { const int tj = 2 * (wave & 1) + tjj; f32x4 acc = (f32x4){0.f, 0.f, 0.f, 0.f};
                    if (tj <= ti) {
#pragma unroll
                        for (int s8 = 0; s8 < 8; ++s8) { const bf16x8 aop = *(const LAS bf16x8*)(KIs + (16 * tj + l15) * 264 + 32 * s8 + 8 * l4), bop = *(const LAS bf16x8*)(QDs + (16 * ti + l15) * 264 + 32 * s8 + 8 * l4);
                            acc = __builtin_amdgcn_mfma_f32_16x16x32_bf16(aop, bop, acc, 0, 0, 0); } }
                    const int ii = 16 * ti + l15, j0 = 16 * tj + 4 * l4;
                    u32x2 w; w.x = pk2(j0 <= ii ? acc[0] : 0.f, j0 + 1 <= ii ? acc[1] : 0.f); w.y = pk2(j0 + 2 <= ii ? acc[2] : 0.f, j0 + 3 <= ii ? acc[3] : 0.f);
                    *(u32x2*)(AMg + ((size_t)u * 64 + ii) * 64 + j0) = w; }
            }
            __syncthreads();
        }
    }
    SEAM(3);

    if (IN(4)) REP(4) {
        typedef short bf16x8 __attribute__((ext_vector_type(8)));
        typedef float f32x16 __attribute__((ext_vector_type(16)));
        LAS bf16* QDb = (LAS bf16*)lds;
        LAS bf16* AMs = QDb + 3 * 64 * 256;
        LAS bf16* VTs = AMs + 2 * 64 * 72;
        LAS bf16* SbT = VTs + 2 * 32 * 72;
        LAS float* DECs = (LAS float*)(SbT + 2 * 32 * 264);
        const int l15 = lane & 15, l4 = lane >> 4, l31 = lane & 31, l5 = lane >> 5;
        unsigned qsrc[4];
#pragma unroll
        for (int j = 0; j < 4; ++j) { const int r = 8 * wave + 2 * j + (lane >> 5); qsrc[j] = (unsigned)(r * 256 + (((lane & 31) ^ (r & 15)) * 8)) * 2u; }
        const unsigned qdst0 = (unsigned)(uintptr_t)QDb + (unsigned)wave * 4096u;
        for (int task = bx; task < 256; task += G) {
            const int pair = (task & 7) * 2 + ((task >> 3) >> 4), slice = (task >> 3) & 15;
            const int b = pair >> 2, h = pair & 3; const size_t u0 = (size_t)pair * 64;
            __syncthreads();
            for (int i = tid; i < 1056; i += NT_BLK) ((LAS u32x4*)SbT)[i] = (u32x4){0u, 0u, 0u, 0u};
            int qcur = 0;
#define G2_GLDS(gsrc, ldsdst) do { unsigned keep_; asm volatile("s_mov_b32 %0, m0\n\ts_mov_b32 m0, %2\n\ts_nop 0\n\tglobal_load_lds_dwordx4 %1, off\n\ts_mov_b32 m0, %0" : "=&s"(keep_) : "v"(gsrc), "s"(ldsdst) : "memory"); } while (0)
#define G2_DMA_Q(nn, buf) do { const char* qb_ = (const char*)(QDg + (u0 + (nn)) * 16384); const unsigned d_ = (unsigned)__builtin_amdgcn_readfirstlane((int)(qdst0 + (unsigned)(buf) * 32768u)); \
            _Pragma("unroll") for (int j_ = 0; j_ < 4; ++j_) G2_GLDS(qb_ + qsrc[j_], d_ + (unsigned)j_ * 1024u); } while (0)
#define G2_DMA_NEXT(n) do { const int nq_ = ((n) + 2 < 64) ? (n) + 2 : (n); const int qn_ = qcur ? qcur - 1 : 2; G2_DMA_Q(nq_, qn_); } while (0)
            if (wave < 4) {
                const int ti = wave;
                u32x4 ra0A, ra1A, rvA; float rdA;
                u32x4 ra0B, ra1B, rvB; float rdB;
#define G2_LOADO(nn, ra0, ra1, rv, rd) do { const size_t u_ = u0 + (nn); const size_t tokc_ = (size_t)b * SEQ + (size_t)(nn) * 64; \
                ra0 = *(const u32x4*)(AMg + u_ * 4096 + (size_t)tid * 8); ra1 = *(const u32x4*)(AMg + u_ * 4096 + (size_t)(tid + 256) * 8); \
                rv = *(const u32x4*)(GV + (tokc_ + (tid >> 2)) * 2048 + h * 512 + slice * 32 + (tid & 3) * 8); rd = DECg[u_ * 256 + tid]; } while (0)
#define G2_STEP_O(n, par, ra0, ra1, rv, rd) do { \
                    LAS bf16* AMn = AMs + (par) * 64 * 72; LAS bf16* VTn = VTs + (par) * 32 * 72; LAS float* DECn = DECs + (par) * 256; \
                    asm volatile("s_waitcnt vmcnt(10)" ::: "memory");       \
                    *(LAS u32x4*)(AMn + (tid >> 3) * 72 + (tid & 7) * 8) = ra0; *(LAS u32x4*)(AMn + ((tid >> 3) + 32) * 72 + (tid & 7) * 8) = ra1; \
                    { LAS bf16* vt = VTn + ((tid & 3) * 8) * 72 + (tid >> 2); \
                      vt[0 * 72] = (bf16)(rv.x & 0xffffu); vt[1 * 72] = (bf16)(rv.x >> 16); vt[2 * 72] = (bf16)(rv.y & 0xffffu); vt[3 * 72] = (bf16)(rv.y >> 16); \
                      vt[4 * 72] = (bf16)(rv.z & 0xffffu); vt[5 * 72] = (bf16)(rv.z >> 16); vt[6 * 72] = (bf16)(rv.w & 0xffffu); vt[7 * 72] = (bf16)(rv.w >> 16); \
                      DECn[tid] = rd; } \
                    __syncthreads(); \
                    G2_DMA_NEXT(n); \
                    { const int nl_ = ((n) + 2 < 64) ? (n) + 2 : (n); G2_LOADO(nl_, ra0, ra1, rv, rd); } \
                    { const LAS bf16* Sb = SbT + (par) * 32 * 264; const LAS bf16* Qb = QDb + qcur * 16384; \
                      f32x4 acc0 = (f32x4){0.f, 0.f, 0.f, 0.f}, acc1 = acc0; \
                      _Pragma("unroll") for (int s8 = 0; s8 < 8; ++s8) { const bf16x8 bop = *(const LAS bf16x8*)(Qb + (16 * ti + l15) * 256 + (((4 * s8 + l4) ^ l15) * 8)); \
                          const bf16x8 aop0 = *(const LAS bf16x8*)(Sb + l15 * 264 + 32 * s8 + 8 * l4), aop1 = *(const LAS bf16x8*)(Sb + (16 + l15) * 264 + 32 * s8 + 8 * l4); \
                          acc0 = __builtin_amdgcn_mfma_f32_16x16x32_bf16(aop0, bop, acc0, 0, 0, 0); acc1 = __builtin_amdgcn_mfma_f32_16x16x32_bf16(aop1, bop, acc1, 0, 0, 0); } \
                      _Pragma("unroll") for (int s2 = 0; s2 < 2; ++s2) { const bf16x8 bop = *(const LAS bf16x8*)(AMn + (16 * ti + l15) * 72 + 32 * s2 + 8 * l4); \
                          const bf16x8 aop0 = *(const LAS bf16x8*)(VTn + l15 * 72 + 32 * s2 + 8 * l4), aop1 = *(const LAS bf16x8*)(VTn + (16 + l15) * 72 + 32 * s2 + 8 * l4); \
                          acc0 = __builtin_amdgcn_mfma_f32_16x16x32_bf16(aop0, bop, acc0, 0, 0, 0); acc1 = __builtin_amdgcn_mfma_f32_16x16x32_bf16(aop1, bop, acc1, 0, 0, 0); } \
                      bf16* op_ = OB + ((size_t)b * SEQ + (size_t)(n) * 64 + 16 * ti + l15) * 2048 + h * 512 + slice * 32 + 4 * l4; \
                      u32x2 w0, w1; w0.x = pk2(acc0[0], acc0[1]); w0.y = pk2(acc0[2], acc0[3]); w1.x = pk2(acc1[0], acc1[1]); w1.y = pk2(acc1[2], acc1[3]); \
                      *(u32x2*)(op_) = w0; *(u32x2*)(op_ + 16) = w1; } \
                    qcur = (qcur == 2) ? 0 : qcur + 1; \
                } while (0)
                G2_LOADO(0, ra0A, ra1A, rvA, rdA); G2_DMA_Q(0, 0); G2_LOADO(1, ra0B, ra1B, rvB, rdB); G2_DMA_Q(1, 1);
                const float dummy0_ = DECg[u0 * 256 + tid], dummy1_ = DECg[u0 * 256 + 256 + tid];
#pragma unroll 1
                for (int n = 0; n < 64; n += 2) {
                    G2_STEP_O(n, 0, ra0A, ra1A, rvA, rdA);
                    G2_STEP_O(n + 1, 1, ra0B, ra1B, rvB, rdB);
                }
                asm volatile("s_waitcnt vmcnt(0)" :: "v"(dummy0_), "v"(dummy1_) : "memory");
#undef G2_STEP_O
#undef G2_LOADO
            } else {
                const int sw = wave - 4;
                f32x16 S0, S1;
#pragma unroll
                for (int r = 0; r < 16; ++r) { S0[r] = 0.f; S1[r] = 0.f; }
                u32x4 rkA[8], rkB[8];
#define G2_LOADK(nn, rk) do { const bf16* kb_ = KTETg + (u0 + (nn)) * 16384 + (size_t)(sw * 4096 + lane * 8); \
                _Pragma("unroll") for (int i_ = 0; i_ < 8; ++i_) rk[i_] = *(const u32x4*)(kb_ + i_ * 512); } while (0)
#define G2_STEP_S(n, par, rk) do { \
                    const LAS bf16* VTn = VTs + (par) * 32 * 72; const LAS float* DECn = DECs + (par) * 256 + 64 * sw + 4 * l5; \
                    asm volatile("s_waitcnt vmcnt(12)" ::: "memory");       \
                    __syncthreads(); \
                    G2_DMA_NEXT(n); \
                    { _Pragma("unroll") for (int g4 = 0; g4 < 4; ++g4) { const f32x4 d0 = *(const LAS f32x4*)(DECn + 8 * g4), d1 = *(const LAS f32x4*)(DECn + 32 + 8 * g4); \
                          S0[4 * g4] *= d0[0]; S0[4 * g4 + 1] *= d0[1]; S0[4 * g4 + 2] *= d0[2]; S0[4 * g4 + 3] *= d0[3]; \
                          S1[4 * g4] *= d1[0]; S1[4 * g4 + 1] *= d1[1]; S1[4 * g4 + 2] *= d1[2]; S1[4 * g4 + 3] *= d1[3]; } \
                      _Pragma("unroll") for (int s4 = 0; s4 < 4; ++s4) { const bf16x8 bop = *(const LAS bf16x8*)(VTn + l31 * 72 + 16 * s4 + 8 * l5); \
                          S0 = __builtin_amdgcn_mfma_f32_32x32x16_bf16(__builtin_bit_cast(bf16x8, rk[s4]), bop, S0, 0, 0, 0); \
                          S1 = __builtin_amdgcn_mfma_f32_32x32x16_bf16(__builtin_bit_cast(bf16x8, rk[4 + s4]), bop, S1, 0, 0, 0); } \
                      LAS bf16* Sn = SbT + (1 - (par)) * 32 * 264 + l31 * 264 + 64 * sw + 4 * l5; \
                      _Pragma("unroll") for (int g4 = 0; g4 < 4; ++g4) { u32x2 w2; w2.x = pk2(S0[4 * g4], S0[4 * g4 + 1]); w2.y = pk2(S0[4 * g4 + 2], S0[4 * g4 + 3]); *(LAS u32x2*)(Sn + 8 * g4) = w2; \
                          u32x2 w3; w3.x = pk2(S1[4 * g4], S1[4 * g4 + 1]); w3.y = pk2(S1[4 * g4 + 2], S1[4 * g4 + 3]); *(LAS u32x2*)(Sn + 32 + 8 * g4) = w3; } } \
                    { const int nl_ = ((n) + 2 < 64) ? (n) + 2 : (n); G2_LOADK(nl_, rk); } \
                    qcur = (qcur == 2) ? 0 : qcur + 1; \
                } while (0)
                G2_LOADK(0, rkA); G2_DMA_Q(0, 0); G2_LOADK(1, rkB); G2_DMA_Q(1, 1);
#pragma unroll 1
                for (int n = 0; n < 64; n += 2) {
                    G2_STEP_S(n, 0, rkA);
                    G2_STEP_S(n + 1, 1, rkB);
                }
                asm volatile("s_waitcnt vmcnt(0)" ::: "memory");
#undef G2_STEP_S
#undef G2_LOADK
            }
#undef G2_DMA_NEXT
#undef G2_DMA_Q
#undef G2_GLDS
        }
        __syncthreads();
    }
    SEAM(4);

    if (IN(5)) {
        const f32x4 ga = *(const f32x4*)(glag + lane * 8), gb2 = *(const f32x4*)(glag + lane * 8 + 4);
        for (int r0 = gw * 4; r0 < M * 4; r0 += NGW * 4) {
            u32x4 ov[4], gv[4];
#pragma unroll
            for (int q = 0; q < 4; ++q) { const size_t off = (size_t)(r0 + q) * 512 + lane * 8; ov[q] = *(const u32x4*)(OB + off); gv[q] = *(const u32x4*)(GR + off); }
#pragma unroll
            for (int q = 0; q < 4; ++q) { const size_t off = (size_t)(r0 + q) * 512 + lane * 8;
                float v[8], gr[8]; unpack8(ov[q], v); unpack8(gv[q], gr);
                float ss = 0.f;
#pragma unroll
                for (int e = 0; e < 8; ++e) ss += v[e] * v[e];
                const float rstd = 1.0f / sqrtf(wave_sum(ss) * (1.f / 512.f) + EPS);
                float y[8];
#pragma unroll
                for (int e = 0; e < 4; ++e) { y[e] = v[e] * rstd * ga[e] * gr[e]; y[4 + e] = v[4 + e] * rstd * gb2[e] * gr[4 + e]; }
                u32x4 w; w.x = pk2(y[0], y[1]); w.y = pk2(y[2], y[3]); w.z = pk2(y[4], y[5]); w.w = pk2(y[6], y[7]);
                *(u32x4*)(OB + off) = w; }
        }
    }
    SEAM(5);

    if (IN(7)) REP(7) {
        pg8::Gemm2 g{YATT, WBA_T, 1024, OB, WBG_T, DM}; pg8::StaticOrder S; S.init(M, DM, G, bx, P7_WGM);
        EpiMerge E{MRG, GA, GB};
        pg8::gemm_phase2<EpiMerge, pg8::StaticOrder>(lds, g, S, E);
    }
    SEAM(7);
    if (IN(8)) REP(8) {
        pg8::Gemm g{MRG, WOUT_T, M, DM, DM}; pg8::StaticOrder S; S.init(M, DM, G, bx, P8_WGM);
        EpiResToBf16 E{x, X1B, MODF + 2 * DM};
        pg8::gemm_phase<EpiResToBf16, pg8::StaticOrder, true, PG8_SP2V>(lds, g, S, E);
    }
    SEAM(8);
    if (IN(9)) REP(9) {
        LAS float* sA = (LAS float*)lds; LAS float* sB = sA + DM;
        const int rows_per = M / G; const int b = (bx * rows_per) >> 12;
        for (int k = tid; k < DM; k += NT_BLK) { sA[k] = g2[k] * (1.f + MODF[(size_t)b * NMOD + 4 * DM + k]); sB[k] = MODF[(size_t)b * NMOD + 3 * DM + k]; }
        __syncthreads();
        for (int r = wave; r < rows_per; r += 2 * NWAVES) {
            const size_t row0 = (size_t)bx * rows_per + r, row1 = row0 + NWAVES;
            const u32x4* xr0 = (const u32x4*)(X1B + row0 * DM) + lane; const u32x4* xr1 = (const u32x4*)(X1B + row1 * DM) + lane; u32x4 p0[4], p1[4];
#pragma unroll
            for (int j = 0; j < 4; ++j) { p0[j] = xr0[64 * j]; p1[j] = xr1[64 * j]; }
            float v0[4][8], v1[4][8]; float ss0 = 0.f, ss1 = 0.f;
#pragma unroll
            for (int j = 0; j < 4; ++j) { unpack8(p0[j], v0[j]); unpack8(p1[j], v1[j]);
#pragma unroll
                for (int e = 0; e < 8; ++e) { ss0 += v0[j][e] * v0[j][e]; ss1 += v1[j][e] * v1[j][e]; } }
            const float rstd0 = 1.0f / sqrtf(wave_sum(ss0) * (1.f / DM) + EPS), rstd1 = 1.0f / sqrtf(wave_sum(ss1) * (1.f / DM) + EPS);
            u32x4* o160 = (u32x4*)(XN + row0 * DM) + lane; u32x4* o161 = (u32x4*)(XN + row1 * DM) + lane;
#pragma unroll
            for (int j = 0; j < 4; ++j) { const int k = 8 * lane + 512 * j; const f32x4 A0 = *(const LAS f32x4*)(sA + k), A1 = *(const LAS f32x4*)(sA + k + 4), B0 = *(const LAS f32x4*)(sB + k), B1 = *(const LAS f32x4*)(sB + k + 4);
                float h0[8], h1[8];
#pragma unroll
                for (int e = 0; e < 4; ++e) { h0[e] = v0[j][e] * rstd0 * A0[e] + B0[e]; h0[4 + e] = v0[j][4 + e] * rstd0 * A1[e] + B1[e]; h1[e] = v1[j][e] * rstd1 * A0[e] + B0[e]; h1[4 + e] = v1[j][4 + e] * rstd1 * A1[e] + B1[e]; }
                u32x4 w0, w1; w0.x = pk2(h0[0], h0[1]); w0.y = pk2(h0[2], h0[3]); w0.z = pk2(h0[4], h0[5]); w0.w = pk2(h0[6], h0[7]);
                w1.x = pk2(h1[0], h1[1]); w1.y = pk2(h1[2], h1[3]); w1.z = pk2(h1[4], h1[5]); w1.w = pk2(h1[6], h1[7]); o160[64 * j] = w0; o161[64 * j] = w1; }
        }
        __syncthreads();
    }
    SEAM(9);
    if (IN(10)) REP(10) {
        pg8::Gemm g{XN, WUP_T, M, NUP, DM}; pg8::StaticOrder S; S.init(M, NUP, G, bx, P10_WGM);
        EpiConvGate E{ACT, HALO, convw, convb, (LAS float*)(lds + 131072)};
        pg8::gemm_phase<EpiConvGate, pg8::StaticOrder, true, PG8_SP2V>(lds, g, S, E);
    }
    SEAM(10);
    if (IN(12)) {
        pg8::Gemm g{ACT, WDN_T, M, DM, DFF}; pg8::StaticOrder S; S.init(M, DM, G, bx, P12_WGM);
        { pg8::Unit uu;
          for (int ui = 0; S.next(ui, uu); ++ui) { const int pm = uu.pm;
            for (int it = tid; it < 2 * (DFF / 4); it += NT_BLK) {
                const int jq = it % (DFF / 4), rr = it / (DFF / 4), j0 = jq * 4;
                const int uc = 256 * (j0 >> 7) + 64 * ((j0 >> 5) & 3) + (j0 & 31); const bool first = (pm & 15) == 0;
                const f32x4 z4 = (f32x4){0.f, 0.f, 0.f, 0.f};
                const float* hc = HALO + (size_t)(pm * 4 + rr) * NUP + uc;
                const float* hp = HALO + (size_t)((pm - 1) * 4) * NUP + uc;
                const f32x4 ua = *(const f32x4*)hc, ub = *(const f32x4*)(hc + 32);
                f32x4 p1a, p1b, p2a, p2b;
                if (rr == 0) { p1a = first ? z4 : *(const f32x4*)(hp + 3 * NUP); p1b = first ? z4 : *(const f32x4*)(hp + 3 * NUP + 32); p2a = first ? z4 : *(const f32x4*)(hp + 2 * NUP); p2b = first ? z4 : *(const f32x4*)(hp + 2 * NUP + 32); }
                else { const float* h0 = HALO + (size_t)(pm * 4) * NUP + uc; p1a = *(const f32x4*)h0; p1b = *(const f32x4*)(h0 + 32); p2a = first ? z4 : *(const f32x4*)(hp + 3 * NUP); p2b = first ? z4 : *(const f32x4*)(hp + 3 * NUP + 32); }
                const f32x4 ya = *(const f32x4*)(convb + j0) + *(const f32x4*)(convw + 2 * (size_t)NUP + j0) * ua + *(const f32x4*)(convw + (size_t)NUP + j0) * p1a + *(const f32x4*)(convw + j0) * p2a;
                const f32x4 yb = *(const f32x4*)(convb + DFF + j0) + *(const f32x4*)(convw + 2 * (size_t)NUP + DFF + j0) * ub + *(const f32x4*)(convw + (size_t)NUP + DFF + j0) * p1b + *(const f32x4*)(convw + DFF + j0) * p2b;
                f32x4 r;
#pragma unroll
                for (int e = 0; e < 4; ++e) r[e] = ya[e] * sigmoidf_(ya[e]) * yb[e];
                u32x2 w; w.x = pk2(r[0], r[1]); w.y = pk2(r[2], r[3]);
                *(u32x2*)(ACT + (size_t)(pm * 256 + rr) * DFF + j0) = w;
            } } }
        asm volatile("s_waitcnt vmcnt(0)" ::: "memory"); __syncthreads();
        EpiResFromBf16 E{X1B, out, MODF + 5 * DM};
        pg8::gemm_phase<EpiResFromBf16, pg8::StaticOrder, true, PG8_SP2V>(lds, g, S, E);
    }
#undef IN
#undef SEAM
}

#ifndef MK_SPLIT
#define MK_SPLIT 0
#endif
constexpr int N_PHASES = 13;
extern "C" void kernel_launch(void* const* d_in, const int* in_sizes, int n_in, void* d_out, int out_size, void* d_ws, size_t ws_size, hipStream_t stream) {
    static int grid = 0;
    if (grid == 0) {
        if (n_in != 21 || out_size != M * DM || ws_size < WS_END) { fprintf(stderr, "kernel_launch: unexpected shapes n_in %d out %d ws %zu\n", n_in, out_size, ws_size); grid = -1; return; }
        int dev = 0, cus = 0, per_cu = 0;
        (void)hipGetDevice(&dev); (void)hipDeviceGetAttribute(&cus, hipDeviceAttributeMultiprocessorCount, dev);
        (void)hipFuncSetAttribute((const void*)fwd_kernel, hipFuncAttributeMaxDynamicSharedMemorySize, LDS_BYTES);
        (void)hipOccupancyMaxActiveBlocksPerMultiprocessor(&per_cu, (const void*)fwd_kernel, NT_BLK, LDS_BYTES);
        fprintf(stderr, "kernel_launch: cus %d per_cu %d ws %zu\n", cus, per_cu, ws_size);
        (void)hipGetLastError();
        grid = cus > 0 ? cus : 256;
    }
    if (grid < 0) return;
    (void)hipMemsetAsync(d_ws, 0, 65536, stream);
    Args a{};
    for (int i = 0; i < 21; ++i) a.in[i] = (const float*)d_in[i];
    a.out = (float*)d_out; a.ws = (unsigned char*)d_ws;
#if MK_SPLIT
    for (int p = 0; p < N_PHASES; ++p) { a.ph_lo = p; a.ph_hi = p + 1; void* args[] = {&a};
        hipError_t e = hipLaunchCooperativeKernel((const void*)fwd_kernel, dim3(grid), dim3(NT_BLK), args, LDS_BYTES, stream);
        if (e != hipSuccess) { fprintf(stderr, "launch %d failed: %s\n", p, hipGetErrorString(e)); break; } }
#else
    a.ph_lo = 0; a.ph_hi = N_PHASES; void* args[] = {&a};
    hipError_t e = hipLaunchCooperativeKernel((const void*)fwd_kernel, dim3(grid), dim3(NT_BLK), args, LDS_BYTES, stream);
    if (e != hipSuccess) fprintf(stderr, "cooperative launch failed: %s (grid %d)\n", hipGetErrorString(e), grid);
#endif
}
```

```cpp
#include <hip/hip_runtime.h>
#include <hip/hip_cooperative_groups.h>
#include <cstdio>
#include <cstdint>
namespace cg = cooperative_groups;

namespace pg8 {
#define PG8_LAS __attribute__((address_space(3)))
typedef unsigned short bf16_t;
typedef short bf16x8 __attribute__((ext_vector_type(8)));
typedef float f32x4 __attribute__((ext_vector_type(4)));
typedef unsigned u32x4 __attribute__((ext_vector_type(4)));
constexpr int BM = 256, BK = 64, HALF = 128, HTB = HALF * BK * 2, STAGE_BYTES = 8 * HTB, NXCD = 8, WGM = 4;

__host__ __device__ __forceinline__ int lds_byte(int r, int c) { const int st = (r >> 4) * 2 + (c >> 5), rr = r & 15, cc = c & 31, ob = rr * 64 + cc * 2; return st * 1024 + (ob ^ (((ob >> 9) & 1) << 5)); }
__host__ __device__ __forceinline__ void stage_rc(int b, int& R, int& C) { const int st = b / 1024, sb = b % 1024, swz = sb ^ (((sb >> 9) & 1) << 5); R = (st >> 1) * 16 + swz / 64; C = (st & 1) * 32 + (swz % 64) / 2; }
__host__ __device__ __forceinline__ int perm32(int rho) { const int n = rho >> 4, i = rho & 15; return 8 * (i >> 2) + 4 * n + (i & 3); }

struct Unit { int pm, pn; };
struct Gemm { const bf16_t* A; const bf16_t* Bt; int M, N, K; };

struct StaticOrder {
    int nM, nN, nwg, G, c, wgm;
    __host__ __device__ void init(int M, int N, int G_, int c_, int wgm_ = WGM) { nM = M / BM; nN = N / BM; nwg = nM * nN; G = G_; c = c_; wgm = wgm_; }
    __host__ __device__ bool next(int i, Unit& u) const {
        const long L = (long)i * G + c; if (L >= nwg) return false;
        int wgid = (int)L; { const int q = nwg / NXCD, r = nwg % NXCD, xcd = wgid % NXCD, off = wgid / NXCD; wgid = (xcd < r ? xcd * (q + 1) : r * (q + 1) + (xcd - r) * q) + off; }
        const int nig = wgm * nN, gid = wgid / nig, fm = gid * wgm, gsz = (nM - fm) < wgm ? (nM - fm) : wgm;
        u.pm = fm + ((wgid % nig) % gsz); u.pn = (wgid % nig) / gsz; return true;
    }
};

__device__ __forceinline__ unsigned cvt_pk_bf16(float lo, float hi) { unsigned r; asm volatile("v_cvt_pk_bf16_f32 %0, %1, %2" : "=v"(r) : "v"(lo), "v"(hi)); return r; }

template <class Epi, class Sched, bool ALIGN_EPI = false, bool SP2 = false>
__device__ __forceinline__ void gemm_phase(PG8_LAS unsigned char* lds, const Gemm g, const Sched& S, const Epi& E) {
    const int tid = threadIdx.x, wid = __builtin_amdgcn_readfirstlane(tid >> 6), lane = tid & 63, wr = wid >> 2, wc = wid & 3, fr = lane & 15, fq = lane >> 4;
    const int K = g.K, nt = K / BK;
    unsigned voffA[2], voffB[2];
#pragma unroll
    for (int i = 0; i < 2; ++i) { int R, C; stage_rc(tid * 16 + i * 8192, R, C); const int Rb = 64 * (R >> 5) + (Epi::PERM ? perm32(R & 31) : (R & 31));
        const int Ra = Epi::ROWP ? ((R & 64) + 4 * (R & 15) + ((R >> 4) & 3)) : R;
        voffA[i] = (unsigned)(Ra * K + C) * 2u; voffB[i] = (unsigned)(Rb * K + C) * 2u; }
    const size_t kstep = (size_t)(BK * 2);
    const size_t hstep = (size_t)HALF * K * 2;
    const size_t hstepB = (size_t)32 * K * 2;
    const size_t tstep = (size_t)BM * K * 2;
    const unsigned ldsw = (unsigned)wid * 1024u;
    const int aoff = lds_byte(wr * 64 + fr, fq * 8), boff = lds_byte(wc * 32 + fr, fq * 8);
#define PG8_SA(b, h) (((b) * 2 + (h)) * HTB)
#define PG8_SB(b, h) ((4 + (b) * 2 + (h)) * HTB)
#define PG8_STAGE(bufoff, gbase, voff) do { _Pragma("unroll") for (int _i = 0; _i < 2; ++_i) \
        __builtin_amdgcn_global_load_lds((const unsigned*)((const char*)(gbase) + (voff)[_i]), (PG8_LAS unsigned*)(lds + (bufoff) + ldsw + _i * 8192), 16, 0, 0); } while (0)
#define PG8_LDA(dst, b, h) do { _Pragma("unroll") for (int m = 0; m < 4; ++m) _Pragma("unroll") for (int k = 0; k < 2; ++k) dst[m][k] = *(const PG8_LAS bf16x8*)(lds + PG8_SA(b, h) + aoff + m * 2048 + k * 1024); } while (0)
#define PG8_LDB(dst, b, h) do { _Pragma("unroll") for (int n = 0; n < 2; ++n) _Pragma("unroll") for (int k = 0; k < 2; ++k) dst[n][k] = *(const PG8_LAS bf16x8*)(lds + PG8_SB(b, h) + boff + n * 2048 + k * 1024); } while (0)
#define PG8_MMA(ai, bj, At, Bt) do { __builtin_amdgcn_s_setprio(1); _Pragma("unroll") for (int m = 0; m < 4; ++m) _Pragma("unroll") for (int n = 0; n < 2; ++n) _Pragma("unroll") for (int k = 0; k < 2; ++k) \
        acc[ai][bj][m][n] = __builtin_amdgcn_mfma_f32_16x16x32_bf16(Bt[n][k], At[m][k], acc[ai][bj][m][n], 0, 0, 0); __builtin_amdgcn_s_setprio(0); } while (0)
#define PG8_WAIT_V(n) asm volatile("s_waitcnt vmcnt(" #n ")" ::: "memory")
#define PG8_WAIT_L(n) asm volatile("s_waitcnt lgkmcnt(" #n ")" ::: "memory")
#define PG8_BAR __builtin_amdgcn_s_barrier()
#define PG8_SCHED __builtin_amdgcn_sched_barrier(0)
    Unit cur, nxt; int ui = 0;
    if (!S.next(0, cur)) return;
    f32x4 acc[2][2][4][2];
#pragma unroll
    for (int a = 0; a < 2; ++a)
#pragma unroll
        for (int b = 0; b < 2; ++b)
#pragma unroll
            for (int m = 0; m < 4; ++m)
#pragma unroll
                for (int n = 0; n < 2; ++n) acc[a][b][m][n] = (f32x4){0.f, 0.f, 0.f, 0.f};
    bf16x8 At[4][2], B0[2][2], B1[2][2];
    const char* cA = (const char*)g.A + (size_t)cur.pm * tstep; const char* cB = (const char*)g.Bt + (size_t)cur.pn * tstep;
    if constexpr (SP2) {
        PG8_STAGE(PG8_SB(0, 0), cB, voffB); PG8_STAGE(PG8_SB(0, 1), cB + hstepB, voffB); PG8_STAGE(PG8_SA(0, 0), cA, voffA); PG8_STAGE(PG8_SA(0, 1), cA + hstep, voffA);
        if (wr == 1) PG8_BAR;
        PG8_WAIT_V(2); PG8_BAR;
        PG8_STAGE(PG8_SB(1, 0), cB + kstep, voffB); PG8_STAGE(PG8_SA(1, 0), cA + kstep, voffA); PG8_STAGE(PG8_SB(1, 1), cB + hstepB + kstep, voffB);
        PG8_WAIT_V(6); PG8_BAR;
    } else {
        PG8_STAGE(PG8_SB(0, 0), cB, voffB); PG8_STAGE(PG8_SA(0, 0), cA, voffA); PG8_STAGE(PG8_SB(0, 1), cB + hstepB, voffB); PG8_STAGE(PG8_SA(0, 1), cA + hstep, voffA);
        if (wr == 1) PG8_BAR;
        PG8_WAIT_V(4); PG8_BAR;
        PG8_STAGE(PG8_SB(1, 0), cB + kstep, voffB); PG8_STAGE(PG8_SA(1, 0), cA + kstep, voffA); PG8_STAGE(PG8_SB(1, 1), cB + hstepB + kstep, voffB);
        PG8_WAIT_V(6); PG8_BAR;
    }
    for (;;) {
        const bool has_next = S.next(ui + 1, nxt);
        const char* nA = has_next ? (const char*)g.A + (size_t)nxt.pm * tstep : cA; const char* nB = has_next ? (const char*)g.Bt + (size_t)nxt.pn * tstep : cB;
        for (int t = 0; t < nt; t += 2) {
            const bool last = (t == nt - 2);
            const char* a1 = cA + (size_t)(t + 1) * kstep;
            const char* a2 = last ? nA : cA + (size_t)(t + 2) * kstep; const char* b2 = last ? nB : cB + (size_t)(t + 2) * kstep;
            const char* a3 = a2 + kstep; const char* b3 = b2 + kstep;
            if constexpr (SP2) {
            PG8_LDB(B0, 0, 0); PG8_LDB(B1, 0, 1); PG8_SCHED; PG8_LDA(At, 0, 0); PG8_STAGE(PG8_SA(1, 1), a1 + hstep, voffA);
            PG8_WAIT_V(8); PG8_WAIT_L(0); PG8_BAR; PG8_MMA(0, 0, At, B0); PG8_MMA(0, 1, At, B1); PG8_BAR; PG8_SCHED;
            PG8_LDA(At, 0, 1); PG8_STAGE(PG8_SB(0, 0), b2, voffB); PG8_STAGE(PG8_SB(0, 1), b2 + hstepB, voffB); PG8_STAGE(PG8_SA(0, 0), a2, voffA);
            PG8_WAIT_V(8); PG8_WAIT_L(0); PG8_BAR; PG8_MMA(1, 0, At, B0); PG8_MMA(1, 1, At, B1); PG8_BAR; PG8_SCHED;
            PG8_LDB(B0, 1, 0); PG8_LDB(B1, 1, 1); PG8_SCHED; PG8_LDA(At, 1, 0); PG8_STAGE(PG8_SA(0, 1), a2 + hstep, voffA);
            PG8_WAIT_V(8); PG8_WAIT_L(0); PG8_BAR; PG8_MMA(0, 0, At, B0); PG8_MMA(0, 1, At, B1); PG8_BAR; PG8_SCHED;
            PG8_LDA(At, 1, 1); PG8_STAGE(PG8_SB(1, 0), b3, voffB); PG8_STAGE(PG8_SB(1, 1), b3 + hstepB, voffB); PG8_STAGE(PG8_SA(1, 0), a3, voffA);
            PG8_WAIT_V(8); PG8_WAIT_L(0); PG8_BAR; PG8_MMA(1, 0, At, B0); PG8_MMA(1, 1, At, B1); PG8_BAR; PG8_SCHED;
            } else {
            PG8_LDB(B0, 0, 0); PG8_SCHED; PG8_LDA(At, 0, 0); PG8_STAGE(PG8_SA(1, 1), a1 + hstep, voffA);
            PG8_WAIT_L(8); PG8_BAR; PG8_WAIT_L(0); PG8_MMA(0, 0, At, B0); PG8_BAR; PG8_SCHED;
            PG8_LDB(B1, 0, 1); PG8_STAGE(PG8_SB(0, 0), b2, voffB);
            PG8_BAR; PG8_WAIT_L(0); PG8_MMA(0, 1, At, B1); PG8_BAR;
            PG8_LDA(At, 0, 1); PG8_STAGE(PG8_SA(0, 0), a2, voffA);
            PG8_BAR; PG8_WAIT_L(0); PG8_MMA(1, 0, At, B0); PG8_BAR; PG8_SCHED;
            PG8_STAGE(PG8_SB(0, 1), b2 + hstepB, voffB);
            PG8_WAIT_V(6); PG8_BAR; PG8_MMA(1, 1, At, B1); PG8_BAR;
            PG8_LDB(B0, 1, 0); PG8_SCHED; PG8_LDA(At, 1, 0); PG8_STAGE(PG8_SA(0, 1), a2 + hstep, voffA);
            PG8_WAIT_L(8); PG8_BAR; PG8_WAIT_L(0); PG8_MMA(0, 0, At, B0); PG8_BAR; PG8_SCHED;
            PG8_LDB(B1, 1, 1); PG8_STAGE(PG8_SB(1, 0), b3, voffB);
            PG8_BAR; PG8_WAIT_L(0); PG8_MMA(0, 1, At, B1); PG8_BAR;
            PG8_LDA(At, 1, 1); PG8_STAGE(PG8_SA(1, 0), a3, voffA);
            PG8_BAR; PG8_WAIT_L(0); PG8_MMA(1, 0, At, B0); PG8_BAR; PG8_SCHED;
            PG8_STAGE(PG8_SB(1, 1), b3 + hstepB, voffB);
            PG8_WAIT_V(6); PG8_BAR; PG8_MMA(1, 1, At, B1); PG8_BAR;
            }
        }
        if constexpr (ALIGN_EPI) { if (wr == 0) PG8_BAR; }
        E(acc, cur, wr, wc, fr, fq);
        if (!has_next) break;
#pragma unroll
        for (int a = 0; a < 2; ++a)
#pragma unroll
            for (int b = 0; b < 2; ++b)
#pragma unroll
                for (int m = 0; m < 4; ++m)
#pragma unroll
                    for (int n = 0; n < 2; ++n) acc[a][b][m][n] = (f32x4){0.f, 0.f, 0.f, 0.f};
        cur = nxt; cA = nA; cB = nB; ++ui;
        if constexpr (ALIGN_EPI) { if (wr == 1) PG8_BAR; }
    }
    PG8_WAIT_V(0);
    if constexpr (!ALIGN_EPI) { if (wr == 0) PG8_BAR; }
    PG8_BAR;
#undef PG8_SA
#undef PG8_SB
#undef PG8_STAGE
#undef PG8_LDA
#undef PG8_LDB
#undef PG8_MMA
#undef PG8_WAIT_V
#undef PG8_WAIT_L
#undef PG8_BAR
#undef PG8_SCHED
}
struct Gemm2 { const bf16_t* A0; const bf16_t* B0; int K0; const bf16_t* A1; const bf16_t* B1; int K1; };
template <class Epi, class Sched>
__device__ __forceinline__ void gemm_phase2(PG8_LAS unsigned char* lds, const Gemm2 g, const Sched& S, const Epi& E) {
    const int tid = threadIdx.x, wid = __builtin_amdgcn_readfirstlane(tid >> 6), lane = tid & 63, wr = wid >> 2, wc = wid & 3, fr = lane & 15, fq = lane >> 4;
    unsigned vA0[2], vB0[2], vA1[2], vB1[2];
#pragma unroll
    for (int i = 0; i < 2; ++i) { int R, C; stage_rc(tid * 16 + i * 8192, R, C); const int Rb = 64 * (R >> 5) + (Epi::PERM ? perm32(R & 31) : (R & 31));
        vA0[i] = (unsigned)(R * g.K0 + C) * 2u; vB0[i] = (unsigned)(Rb * g.K0 + C) * 2u; vA1[i] = (unsigned)(R * g.K1 + C) * 2u; vB1[i] = (unsigned)(Rb * g.K1 + C) * 2u; }
    const size_t kstep = (size_t)(BK * 2);
    const size_t hA0 = (size_t)HALF * g.K0 * 2, hB0 = (size_t)32 * g.K0 * 2, ts0 = (size_t)BM * g.K0 * 2;
    const size_t hA1 = (size_t)HALF * g.K1 * 2, hB1 = (size_t)32 * g.K1 * 2, ts1 = (size_t)BM * g.K1 * 2;
    const unsigned ldsw = (unsigned)wid * 1024u;
    const int aoff = lds_byte(wr * 64 + fr, fq * 8), boff = lds_byte(wc * 32 + fr, fq * 8);
#define PG8_SA(b, h) (((b) * 2 + (h)) * HTB)
#define PG8_SB(b, h) ((4 + (b) * 2 + (h)) * HTB)
#define PG8_STAGE(bufoff, gbase, voff) do { _Pragma("unroll") for (int _i = 0; _i < 2; ++_i) \
        __builtin_amdgcn_global_load_lds((const unsigned*)((const char*)(gbase) + (voff)[_i]), (PG8_LAS unsigned*)(lds + (bufoff) + ldsw + _i * 8192), 16, 0, 0); } while (0)
#define PG8_LDA(dst, b, h) do { _Pragma("unroll") for (int m = 0; m < 4; ++m) _Pragma("unroll") for (int k = 0; k < 2; ++k) dst[m][k] = *(const PG8_LAS bf16x8*)(lds + PG8_SA(b, h) + aoff + m * 2048 + k * 1024); } while (0)
#define PG8_LDB(dst, b, h) do { _Pragma("unroll") for (int n = 0; n < 2; ++n) _Pragma("unroll") for (int k = 0; k < 2; ++k) dst[n][k] = *(const PG8_LAS bf16x8*)(lds + PG8_SB(b, h) + boff + n * 2048 + k * 1024); } while (0)
#define PG8_MMA(ai, bj, At, Bt) do { __builtin_amdgcn_s_setprio(1); _Pragma("unroll") for (int m = 0; m < 4; ++m) _Pragma("unroll") for (int n = 0; n < 2; ++n) _Pragma("unroll") for (int k = 0; k < 2; ++k) \
        acc[ai][bj][m][n] = __builtin_amdgcn_mfma_f32_16x16x32_bf16(Bt[n][k], At[m][k], acc[ai][bj][m][n], 0, 0, 0); __builtin_amdgcn_s_setprio(0); } while (0)
#define PG8_WAIT_V(n) asm volatile("s_waitcnt vmcnt(" #n ")" ::: "memory")
#define PG8_WAIT_L(n) asm volatile("s_waitcnt lgkmcnt(" #n ")" ::: "memory")
#define PG8_BAR __builtin_amdgcn_s_barrier()
#define PG8_SCHED __builtin_amdgcn_sched_barrier(0)
    Unit cur, nxt; int ui = 0, seg = 0;
    if (!S.next(0, cur)) return;
    f32x4 acc[2][2][4][2];
#pragma unroll
    for (int a = 0; a < 2; ++a)
#pragma unroll
        for (int b = 0; b < 2; ++b)
#pragma unroll
            for (int m = 0; m < 4; ++m)
#pragma unroll
                for (int n = 0; n < 2; ++n) acc[a][b][m][n] = (f32x4){0.f, 0.f, 0.f, 0.f};
    bf16x8 At[4][2], B0[2][2], B1[2][2];
    const char* cA = (const char*)g.A0 + (size_t)cur.pm * ts0; const char* cB = (const char*)g.B0 + (size_t)cur.pn * ts0;
    unsigned cvA[2] = {vA0[0], vA0[1]}, cvB[2] = {vB0[0], vB0[1]}; size_t chA = hA0, chB = hB0; int nt = g.K0 / BK;
    PG8_STAGE(PG8_SB(0, 0), cB, cvB); PG8_STAGE(PG8_SB(0, 1), cB + chB, cvB); PG8_STAGE(PG8_SA(0, 0), cA, cvA); PG8_STAGE(PG8_SA(0, 1), cA + chA, cvA);
    if (wr == 1) PG8_BAR;
    PG8_WAIT_V(2); PG8_BAR;
    PG8_STAGE(PG8_SB(1, 0), cB + kstep, cvB); PG8_STAGE(PG8_SA(1, 0), cA + kstep, cvA); PG8_STAGE(PG8_SB(1, 1), cB + chB + kstep, cvB);
    PG8_WAIT_V(6); PG8_BAR;
    for (;;) {
        bool has_next = true; const char* nA; const char* nB; unsigned nvA[2], nvB[2]; size_t nhA, nhB; int nnt;
        if (seg == 0) { nA = (const char*)g.A1 + (size_t)cur.pm * ts1; nB = (const char*)g.B1 + (size_t)cur.pn * ts1; nvA[0] = vA1[0]; nvA[1] = vA1[1]; nvB[0] = vB1[0]; nvB[1] = vB1[1]; nhA = hA1; nhB = hB1; nnt = g.K1 / BK; }
        else { has_next = S.next(ui + 1, nxt);
            if (has_next) { nA = (const char*)g.A0 + (size_t)nxt.pm * ts0; nB = (const char*)g.B0 + (size_t)nxt.pn * ts0; nvA[0] = vA0[0]; nvA[1] = vA0[1]; nvB[0] = vB0[0]; nvB[1] = vB0[1]; nhA = hA0; nhB = hB0; nnt = g.K0 / BK; }
            else { nA = cA; nB = cB; nvA[0] = cvA[0]; nvA[1] = cvA[1]; nvB[0] = cvB[0]; nvB[1] = cvB[1]; nhA = chA; nhB = chB; nnt = nt; } }
        for (int t = 0; t < nt; t += 2) {
            const bool last = (t == nt - 2);
            const char* a1 = cA + (size_t)(t + 1) * kstep;
            const char* a2 = last ? nA : cA + (size_t)(t + 2) * kstep; const char* b2 = last ? nB : cB + (size_t)(t + 2) * kstep;
            const char* a3 = a2 + kstep; const char* b3 = b2 + kstep;
            unsigned xA[2], xB[2]; xA[0] = last ? nvA[0] : cvA[0]; xA[1] = last ? nvA[1] : cvA[1]; xB[0] = last ? nvB[0] : cvB[0]; xB[1] = last ? nvB[1] : cvB[1];
            const size_t xhA = last ? nhA : chA, xhB = last ? nhB : chB;
            PG8_LDB(B0, 0, 0); PG8_LDB(B1, 0, 1); PG8_SCHED; PG8_LDA(At, 0, 0); PG8_STAGE(PG8_SA(1, 1), a1 + chA, cvA);
            PG8_WAIT_V(8); PG8_WAIT_L(0); PG8_BAR; PG8_MMA(0, 0, At, B0); PG8_MMA(0, 1, At, B1); PG8_BAR; PG8_SCHED;
            PG8_LDA(At, 0, 1); PG8_STAGE(PG8_SB(0, 0), b2, xB); PG8_STAGE(PG8_SB(0, 1), b2 + xhB, xB); PG8_STAGE(PG8_SA(0, 0), a2, xA);
            PG8_WAIT_V(8); PG8_WAIT_L(0); PG8_BAR; PG8_MMA(1, 0, At, B0); PG8_MMA(1, 1, At, B1); PG8_BAR; PG8_SCHED;
            PG8_LDB(B0, 1, 0); PG8_LDB(B1, 1, 1); PG8_SCHED; PG8_LDA(At, 1, 0); PG8_STAGE(PG8_SA(0, 1), a2 + xhA, xA);
            PG8_WAIT_V(8); PG8_WAIT_L(0); PG8_BAR; PG8_MMA(0, 0, At, B0); PG8_MMA(0, 1, At, B1); PG8_BAR; PG8_SCHED;
            PG8_LDA(At, 1, 1); PG8_STAGE(PG8_SB(1, 0), b3, xB); PG8_STAGE(PG8_SB(1, 1), b3 + xhB, xB); PG8_STAGE(PG8_SA(1, 0), a3, xA);
            PG8_WAIT_V(8); PG8_WAIT_L(0); PG8_BAR; PG8_MMA(1, 0, At, B0); PG8_MMA(1, 1, At, B1); PG8_BAR; PG8_SCHED;
        }
        if (wr == 0) PG8_BAR;
        if (seg == 0) E.mid(acc, cur, wr, wc, fr, fq); else E(acc, cur, wr, wc, fr, fq);
        if (seg == 1 && !has_next) break;
        if (seg == 1) {
#pragma unroll
            for (int a = 0; a < 2; ++a)
#pragma unroll
                for (int b = 0; b < 2; ++b)
#pragma unroll
                    for (int m = 0; m < 4; ++m)
#pragma unroll
                        for (int n = 0; n < 2; ++n) acc[a][b][m][n] = (f32x4){0.f, 0.f, 0.f, 0.f};
            cur = nxt; ++ui; }
        seg ^= 1; cA = nA; cB = nB; cvA[0] = nvA[0]; cvA[1] = nvA[1]; cvB[0] = nvB[0]; cvB[1] = nvB[1]; chA = nhA; chB = nhB; nt = nnt;
        if (wr == 1) PG8_BAR;
    }
    PG8_WAIT_V(0);
    PG8_BAR;
#undef PG8_SA
#undef PG8_SB
#undef PG8_STAGE
#undef PG8_LDA
#undef PG8_LDB
#undef PG8_MMA
#undef PG8_WAIT_V
#undef PG8_WAIT_L
#undef PG8_BAR
#undef PG8_SCHED
}
}

#define P2_WGM 4
#define P7_WGM 4
#define P8_WGM 4
#define P10_WGM 8
#define P12_WGM 4
#ifndef PG8_SP2V
#define PG8_SP2V true
#endif
typedef unsigned short bf16;
typedef float f32x4 __attribute__((ext_vector_type(4)));
typedef unsigned u32x4 __attribute__((ext_vector_type(4)));
typedef unsigned u32x2 __attribute__((ext_vector_type(2)));
#define LAS __attribute__((address_space(3)))
constexpr int NWAVES = 8, NT_BLK = 512;
constexpr int DM = 2048, BATCH = 4, SEQ = 4096, M = BATCH * SEQ;
constexpr int D_IN = 11792, NIN_PAD = 12032;
constexpr int DFF = 5632, NUP = 2 * DFF;
constexpr int NMOD = 6 * DM;
constexpr float EPS = 1e-6f;
constexpr int ADA_KS = 32;

constexpr size_t MiB = 1u << 20;
constexpr size_t WS_MODP = 64 * 1024;
constexpr size_t WS_MODF = 0 * MiB + 65536;
constexpr size_t WS_WIN  = 2 * MiB;
constexpr size_t WS_YATT = 2 * MiB;
constexpr size_t WS_XN   = 49 * MiB;
constexpr size_t WS_O    = 182 * MiB;
constexpr size_t WS_AM = 34 * MiB, WS_DEC = 42 * MiB, WS_QD = 49 * MiB, WS_KTET = 81 * MiB;
constexpr size_t WS_WBA  = 113 * MiB, WS_WBG = 117 * MiB, WS_WOUT = 125 * MiB;
constexpr size_t WS_GLR  = 133 * MiB;
constexpr size_t WS_AQ = 134 * MiB, WS_AK = 166 * MiB, WS_AV = 174 * MiB, WS_GQ = 182 * MiB, WS_GK = 214 * MiB;
constexpr size_t WS_GV = 246 * MiB, WS_GR = 310 * MiB;
constexpr size_t WS_MODP2 = 502 * MiB;
constexpr size_t WS_M1   = 49 * MiB;
constexpr size_t WS_MRG  = 310 * MiB;
constexpr size_t WS_WUP  = 374 * MiB;
constexpr size_t WS_WDN  = 418 * MiB;
constexpr size_t WS_ACT  = 113 * MiB;
constexpr size_t WS_CWS  = 1 * MiB;
constexpr size_t WS_HALO = 290 * MiB;
constexpr size_t WS_X1B  = 440 * MiB;
constexpr size_t WS_END  = 512 * MiB;

constexpr int LDS_BYTES = 163840;

__device__ __forceinline__ float bf2f(unsigned v) { return __uint_as_float(v << 16); }
__device__ __forceinline__ unsigned f2bf(float f) { unsigned u = __float_as_uint(f); return (u + 0x7fffu + ((u >> 16) & 1u)) >> 16; }
typedef float f32x2_t __attribute__((ext_vector_type(2))); typedef __bf16 bf16x2_t __attribute__((ext_vector_type(2)));
__device__ __forceinline__ unsigned pk2(float lo, float hi) { f32x2_t v = {lo, hi}; bf16x2_t b = __builtin_convertvector(v, bf16x2_t); return __builtin_bit_cast(unsigned, b); }
__device__ __forceinline__ float sigmoidf_(float x) { return __builtin_amdgcn_rcpf(1.f + __builtin_amdgcn_exp2f(-1.4426950408889634f * x)); }
__device__ __forceinline__ float wave_sum(float v) {
#pragma unroll
    for (int o = 1; o < 64; o <<= 1) v += __shfl_xor(v, o);
    return v;
}
__device__ __forceinline__ void unpack8(const u32x4 w, float (&f)[8]) {
    f[0] = bf2f(w.x & 0xffffu); f[1] = bf2f(w.x >> 16); f[2] = bf2f(w.y & 0xffffu); f[3] = bf2f(w.y >> 16);
    f[4] = bf2f(w.z & 0xffffu); f[5] = bf2f(w.z >> 16); f[6] = bf2f(w.w & 0xffffu); f[7] = bf2f(w.w >> 16);
}

__device__ __forceinline__ void unpack8u(const u32x2 w, float (&f)[8]) {
    const float k = 1.0f / 255.0f;
    f[0] = (float)(w.x & 0xffu) * k; f[1] = (float)((w.x >> 8) & 0xffu) * k; f[2] = (float)((w.x >> 16) & 0xffu) * k; f[3] = (float)(w.x >> 24) * k;
    f[4] = (float)(w.y & 0xffu) * k; f[5] = (float)((w.y >> 8) & 0xffu) * k; f[6] = (float)((w.y >> 16) & 0xffu) * k; f[7] = (float)(w.y >> 24) * k;
}
using pg8::Unit;
struct EpiInProj {
    static constexpr bool PERM = true; static constexpr bool ROWP = false;
    bf16 *AQ, *AK, *AV, *GQ, *GK, *GV, *GR; bf16* GA; unsigned char* GB; float* GLR; const float *qg, *kg;
    __device__ __forceinline__ void operator()(const f32x4 (&acc)[2][2][4][2], const Unit& u, int wr, int wc, int fr, int fq) const {
        const int pn = u.pn; const int rowb = u.pm * 256 + wr * 64 + fr; const int cw = 64 * wc + 8 * fq;
        if (pn < 5) {
            bf16* dst; int ld; const float* gain; float sc;
            if (pn < 4) { dst = AQ + pn * 256; ld = 1024; gain = qg; sc = 0.125f; } else { dst = AK; ld = 256; gain = kg; sc = 1.f; }
            f32x4 g[2][2];
#pragma unroll
            for (int bj = 0; bj < 2; ++bj)
#pragma unroll
                for (int n = 0; n < 2; ++n) g[bj][n] = *(const f32x4*)(gain + 32 * bj + 8 * fq + 4 * n) * sc;
#pragma unroll
            for (int ai = 0; ai < 2; ++ai)
#pragma unroll
                for (int m = 0; m < 4; ++m) {
                    float ss = 0.f;
#pragma unroll
                    for (int bj = 0; bj < 2; ++bj)
#pragma unroll
                        for (int n = 0; n < 2; ++n) { const f32x4 v = acc[ai][bj][m][n]; ss += (v[0] * v[0] + v[1] * v[1]) + (v[2] * v[2] + v[3] * v[3]); }
                    ss += __shfl_xor(ss, 16); ss += __shfl_xor(ss, 32);
                    const float r = 1.0f / sqrtf(ss * (1.f / 64.f) + EPS);
                    bf16* rowp = dst + (size_t)(rowb + ai * 128 + m * 16) * ld + cw;
#pragma unroll
                    for (int bj = 0; bj < 2; ++bj) { const f32x4 v0 = acc[ai][bj][m][0] * r * g[bj][0], v1 = acc[ai][bj][m][1] * r * g[bj][1];
                        u32x4 w; w.x = pk2(v0[0], v0[1]); w.y = pk2(v0[2], v0[3]); w.z = pk2(v1[0], v1[1]); w.w = pk2(v1[2], v1[3]);
                        *(u32x4*)(rowp + 32 * bj) = w; }
                }
        } else if (pn == 46) {
            if (wc == 0 && fq < 2) {
#pragma unroll
                for (int ai = 0; ai < 2; ++ai)
#pragma unroll
                    for (int m = 0; m < 4; ++m) { float* rowp = GLR + (size_t)(rowb + ai * 128 + m * 16) * 16 + 8 * fq;
                        *(f32x4*)(rowp) = acc[ai][0][m][0]; *(f32x4*)(rowp + 4) = acc[ai][0][m][1]; }
            }
        } else {
            bf16* dst; int ld; int act;
            if (pn == 5)       { dst = AV; ld = 256; act = 0; }
            else if (pn < 10)  { dst = GQ + (pn - 6) * 256;  ld = 1024; act = 1; }
            else if (pn < 14)  { dst = GK + (pn - 10) * 256; ld = 1024; act = 0; }
            else if (pn < 22)  { dst = GV + (pn - 14) * 256; ld = 2048; act = 0; }
            else if (pn < 30)  { dst = GR + (pn - 22) * 256; ld = 2048; act = 2; }
            else {
                const int jc = (pn - 30) * 128 + 32 * wc + 8 * fq;
#pragma unroll
                for (int ai = 0; ai < 2; ++ai)
#pragma unroll
                    for (int m = 0; m < 4; ++m) { const size_t ro = (size_t)(rowb + ai * 128 + m * 16) * 2048 + jc; float rho[8]; unsigned q[8];
#pragma unroll
                        for (int n = 0; n < 2; ++n)
#pragma unroll
                            for (int e = 0; e < 4; ++e) { const float da = 1.f + __builtin_amdgcn_exp2f(-1.4426950408889634f * acc[ai][0][m][n][e]), db = 1.f + __builtin_amdgcn_exp2f(-1.4426950408889634f * acc[ai][1][m][n][e]);
                                const float qf = fmaxf(1.0f, rintf(255.0f * __builtin_amdgcn_rcpf(db))); q[4 * n + e] = (unsigned)qf;
                                rho[4 * n + e] = __builtin_amdgcn_rcpf(da * (qf * (1.0f / 255.0f))); }
                        u32x4 w; w.x = pk2(rho[0], rho[1]); w.y = pk2(rho[2], rho[3]); w.z = pk2(rho[4], rho[5]); w.w = pk2(rho[6], rho[7]);
                        *(u32x4*)(GA + ro) = w;
                        u32x2 w8; w8.x = q[0] | (q[1] << 8) | (q[2] << 16) | (q[3] << 24); w8.y = q[4] | (q[5] << 8) | (q[6] << 16) | (q[7] << 24);
                        *(u32x2*)(GB + ro) = w8; }
                return; }
#pragma unroll
            for (int ai = 0; ai < 2; ++ai)
#pragma unroll
                for (int m = 0; m < 4; ++m) { bf16* rowp = dst + (size_t)(rowb + ai * 128 + m * 16) * ld + cw;
#pragma unroll
                    for (int bj = 0; bj < 2; ++bj) { f32x4 v0 = acc[ai][bj][m][0], v1 = acc[ai][bj][m][1];
                        if (act == 1) { v0 = v0 * 0.0625f; v1 = v1 * 0.0625f; }
                        else if (act >= 2) {
#pragma unroll
                            for (int e = 0; e < 4; ++e) { const float s0 = sigmoidf_(v0[e]), s1 = sigmoidf_(v1[e]); v0[e] = (act == 2) ? v0[e] * s0 : s0; v1[e] = (act == 2) ? v1[e] * s1 : s1; } }
                        u32x4 w; w.x = pk2(v0[0], v0[1]); w.y = pk2(v0[2], v0[3]); w.z = pk2(v1[0], v1[1]); w.w = pk2(v1[2], v1[3]);
                        *(u32x4*)(rowp + 32 * bj) = w; } }
        }
    }
};
template <int MODE  > struct EpiBf16Gate {
    static constexpr bool PERM = true; static constexpr bool ROWP = false;
    bf16* O; int ldc; const bf16* G; const bf16* ADD;
    __device__ __forceinline__ void operator()(const f32x4 (&acc)[2][2][4][2], const Unit& u, int wr, int wc, int fr, int fq) const {
        const int rowb = u.pm * 256 + wr * 64 + fr; const int col0 = u.pn * 256 + 64 * wc + 8 * fq;
#pragma unroll
        for (int ai = 0; ai < 2; ++ai)
#pragma unroll
            for (int m = 0; m < 4; ++m) { const size_t ro = (size_t)(rowb + ai * 128 + m * 16) * ldc + col0;
#pragma unroll
                for (int bj = 0; bj < 2; ++bj) { float v[8];
#pragma unroll
                    for (int e = 0; e < 4; ++e) { v[e] = acc[ai][bj][m][0][e]; v[4 + e] = acc[ai][bj][m][1][e]; }
                    if (MODE >= 1) { float gg[8]; unpack8(*(const u32x4*)(G + ro + 32 * bj), gg);
#pragma unroll
                        for (int e = 0; e < 8; ++e) v[e] *= gg[e]; }
                    if (MODE == 2) { float aa[8]; unpack8(*(const u32x4*)(ADD + ro + 32 * bj), aa);
#pragma unroll
                        for (int e = 0; e < 8; ++e) v[e] += aa[e]; }
                    u32x4 w; w.x = pk2(v[0], v[1]); w.y = pk2(v[2], v[3]); w.z = pk2(v[4], v[5]); w.w = pk2(v[6], v[7]);
                    *(u32x4*)(O + ro + 32 * bj) = w; } }
    }
};
struct EpiRes {
    static constexpr bool PERM = false; static constexpr bool ROWP = false;
    const float* base; float* out; const float* gate; int row_base;
    __device__ __forceinline__ void operator()(const f32x4 (&acc)[2][2][4][2], const Unit& u, int wr, int wc, int fr, int fq) const {
        const int rowb = u.pm * 256 + wr * 64 + fr; const int col0 = u.pn * 256 + 64 * wc + 4 * fq;
        const int b = (row_base + u.pm * 256) >> 12;
        f32x4 gv[2][2];
#pragma unroll
        for (int bj = 0; bj < 2; ++bj)
#pragma unroll
            for (int n = 0; n < 2; ++n) gv[bj][n] = *(const f32x4*)(gate + (size_t)b * NMOD + col0 + 32 * bj + 16 * n);
#pragma unroll
        for (int ai = 0; ai < 2; ++ai)
#pragma unroll
            for (int m = 0; m < 4; ++m) { const size_t ro = (size_t)(rowb + ai * 128 + m * 16) * DM + col0;
#pragma unroll
                for (int bj = 0; bj < 2; ++bj)
#pragma unroll
                    for (int n = 0; n < 2; ++n) { const f32x4 bs = *(const f32x4*)(base + ro + 32 * bj + 16 * n);
                        *(f32x4*)(out + ro + 32 * bj + 16 * n) = bs + gv[bj][n] * acc[ai][bj][m][n]; } }
    }
};

struct EpiResToBf16 {
    static constexpr bool PERM = true; static constexpr bool ROWP = false;
    const float* base; bf16* out; const float* gate;
    __device__ __forceinline__ void operator()(const f32x4 (&acc)[2][2][4][2], const Unit& u, int wr, int wc, int fr, int fq) const {
        const int rowb = u.pm * 256 + wr * 64 + fr; const int col0 = u.pn * 256 + 64 * wc + 8 * fq;
        const int b = (u.pm * 256) >> 12;
        f32x4 gv[2][2];
#pragma unroll
        for (int bj = 0; bj < 2; ++bj)
#pragma unroll
            for (int n = 0; n < 2; ++n) gv[bj][n] = *(const f32x4*)(gate + (size_t)b * NMOD + col0 + 32 * bj + 4 * n);
#pragma unroll
        for (int ai = 0; ai < 2; ++ai)
#pragma unroll
            for (int m = 0; m < 4; ++m) { const size_t ro = (size_t)(rowb + ai * 128 + m * 16) * DM + col0;
#pragma unroll
                for (int bj = 0; bj < 2; ++bj) { const f32x4 b0 = *(const f32x4*)(base + ro + 32 * bj), b1 = *(const f32x4*)(base + ro + 32 * bj + 4);
                    const f32x4 v0 = b0 + gv[bj][0] * acc[ai][bj][m][0], v1 = b1 + gv[bj][1] * acc[ai][bj][m][1];
                    u32x4 w; w.x = pk2(v0[0], v0[1]); w.y = pk2(v0[2], v0[3]); w.z = pk2(v1[0], v1[1]); w.w = pk2(v1[2], v1[3]);
                    *(u32x4*)(out + ro + 32 * bj) = w; } }
    }
};
struct EpiResFromBf16 {
    static constexpr bool PERM = false; static constexpr bool ROWP = false;
    const bf16* base; float* out; const float* gate;
    __device__ __forceinline__ void operator()(const f32x4 (&acc)[2][2][4][2], const Unit& u, int wr, int wc, int fr, int fq) const {
        const int rowb = u.pm * 256 + wr * 64 + fr; const int col0 = u.pn * 256 + 64 * wc + 4 * fq;
        const int b = (u.pm * 256) >> 12;
        f32x4 gv[2][2];
#pragma unroll
        for (int bj = 0; bj < 2; ++bj)
#pragma unroll
            for (int n = 0; n < 2; ++n) gv[bj][n] = *(const f32x4*)(gate + (size_t)b * NMOD + col0 + 32 * bj + 16 * n);
#pragma unroll
        for (int ai = 0; ai < 2; ++ai)
#pragma unroll
            for (int m = 0; m < 4; ++m) { const size_t ro = (size_t)(rowb + ai * 128 + m * 16) * DM + col0;
#pragma unroll
                for (int bj = 0; bj < 2; ++bj)
#pragma unroll
                    for (int n = 0; n < 2; ++n) { const u32x2 bw = *(const u32x2*)(base + ro + 32 * bj + 16 * n);
                        const f32x4 bs = (f32x4){bf2f(bw.x & 0xffffu), bf2f(bw.x >> 16), bf2f(bw.y & 0xffffu), bf2f(bw.y >> 16)};
                        *(f32x4*)(out + ro + 32 * bj + 16 * n) = bs + gv[bj][n] * acc[ai][bj][m][n]; } }
    }
};
__device__ __forceinline__ f32x4 dpp_shr1(f32x4 old, f32x4 v) { f32x4 r;
#pragma unroll
    for (int e = 0; e < 4; ++e) r[e] = __int_as_float(__builtin_amdgcn_update_dpp(__float_as_int(old[e]), __float_as_int(v[e]), 0x111, 0xf, 0xf, false)); return r; }
struct EpiConvGate {
    static constexpr bool PERM = true; static constexpr bool ROWP = true;
    bf16* ACT; float* HALO; const float* cw; const float* cb; LAS float* xch;
    __device__ __forceinline__ void operator()(const f32x4 (&acc)[2][2][4][2], const Unit& u, int wr, int wc, int fr, int fq) const {
        const int pm = u.pm, pn = u.pn;
        f32x4 wa2[2][3], wb2[2][3], ba2[2], bb2[2];
#pragma unroll
        for (int n = 0; n < 2; ++n) { const int j0 = 128 * pn + 32 * wc + 8 * fq + 4 * n;
#pragma unroll
          for (int tap = 0; tap < 3; ++tap) { wa2[n][tap] = *(const f32x4*)(cw + (size_t)tap * NUP + j0); wb2[n][tap] = *(const f32x4*)(cw + (size_t)tap * NUP + DFF + j0); }
          ba2[n] = *(const f32x4*)(cb + j0); bb2[n] = *(const f32x4*)(cb + DFF + j0); }
        if (fr == 15) {
#pragma unroll
            for (int ai = 0; ai < 2; ++ai)
#pragma unroll
                for (int bj = 0; bj < 2; ++bj)
#pragma unroll
                    for (int n = 0; n < 2; ++n) { LAS float* d = xch + (((ai * 2 + wr) * 4 + wc) * 2) * 64 + 32 * bj + 8 * fq + 4 * n;
                        *(LAS f32x4*)(d) = acc[ai][bj][2][n]; *(LAS f32x4*)(d + 64) = acc[ai][bj][3][n]; }
        }
        { const int colh = pn * 256 + 64 * wc + 8 * fq;
          if (wr == 0 && fr == 0) {
#pragma unroll
            for (int bj = 0; bj < 2; ++bj)
#pragma unroll
                for (int n = 0; n < 2; ++n) { *(f32x4*)(HALO + (size_t)(pm * 4 + 0) * NUP + colh + 32 * bj + 4 * n) = acc[0][bj][0][n]; *(f32x4*)(HALO + (size_t)(pm * 4 + 1) * NUP + colh + 32 * bj + 4 * n) = acc[0][bj][1][n]; }
          }
          if (wr == 1 && fr == 15) {
#pragma unroll
            for (int bj = 0; bj < 2; ++bj)
#pragma unroll
                for (int n = 0; n < 2; ++n) { *(f32x4*)(HALO + (size_t)(pm * 4 + 2) * NUP + colh + 32 * bj + 4 * n) = acc[1][bj][2][n]; *(f32x4*)(HALO + (size_t)(pm * 4 + 3) * NUP + colh + 32 * bj + 4 * n) = acc[1][bj][3][n]; }
          } }
        asm volatile("s_waitcnt lgkmcnt(0)" ::: "memory"); __builtin_amdgcn_s_barrier(); asm volatile("" ::: "memory");
#pragma unroll
        for (int n = 0; n < 2; ++n) {
            const int j0 = 128 * pn + 32 * wc + 8 * fq + 4 * n;
            const f32x4 (&wa)[3] = wa2[n]; const f32x4 (&wb)[3] = wb2[n]; const f32x4 ba = ba2[n], bb = bb2[n];
#pragma unroll
            for (int ai = 0; ai < 2; ++ai) {
                f32x4 a62 = (f32x4){0.f, 0.f, 0.f, 0.f}, a63 = a62, b62 = a62, b63 = a62;
                if (wr == 1 || ai == 1) {
                    const int sai = (wr == 1) ? ai : ai - 1, swr = 1 - wr;
                    const LAS float* src = xch + (((sai * 2 + swr) * 4 + wc) * 2) * 64 + 8 * fq + 4 * n;
                    a62 = *(const LAS f32x4*)(src); a63 = *(const LAS f32x4*)(src + 64); b62 = *(const LAS f32x4*)(src + 32); b63 = *(const LAS f32x4*)(src + 96);
                }
                const f32x4 ua0 = acc[ai][0][0][n], ua1 = acc[ai][0][1][n], ua2 = acc[ai][0][2][n], ua3 = acc[ai][0][3][n];
                const f32x4 ub0 = acc[ai][1][0][n], ub1 = acc[ai][1][1][n], ub2 = acc[ai][1][2][n], ub3 = acc[ai][1][3][n];
                const f32x4 sa3 = dpp_shr1(a63, ua3), sa2 = dpp_shr1(a62, ua2), sb3 = dpp_shr1(b63, ub3), sb2 = dpp_shr1(b62, ub2);
                f32x4 ya[4], yb[4];
                ya[0] = ba + wa[2] * ua0 + wa[1] * sa3 + wa[0] * sa2; yb[0] = bb + wb[2] * ub0 + wb[1] * sb3 + wb[0] * sb2;
                ya[1] = ba + wa[2] * ua1 + wa[1] * ua0 + wa[0] * sa3; yb[1] = bb + wb[2] * ub1 + wb[1] * ub0 + wb[0] * sb3;
                ya[2] = ba + wa[2] * ua2 + wa[1] * ua1 + wa[0] * ua0; yb[2] = bb + wb[2] * ub2 + wb[1] * ub1 + wb[0] * ub0;
                ya[3] = ba + wa[2] * ua3 + wa[1] * ua2 + wa[0] * ua1; yb[3] = bb + wb[2] * ub3 + wb[1] * ub2 + wb[0] * ub1;
#pragma unroll
                for (int m = 0; m < 4; ++m) {
                    f32x4 r;
#pragma unroll
                    for (int e = 0; e < 4; ++e) r[e] = ya[m][e] * yb[m][e] * __builtin_amdgcn_rcpf(1.f + __builtin_amdgcn_exp2f(ya[m][e]));
                    const bool skip = (ai == 0) && (wr == 0) && (m < 2) && (fr == 0);
                    if (!skip) { u32x2 w; w.x = pk2(r[0], r[1]); w.y = pk2(r[2], r[3]);
                        *(u32x2*)(ACT + (size_t)(pm * 256 + ai * 128 + wr * 64 + 4 * fr + m) * DFF + j0) = w; }
                }
            }
        }
    }
};

struct EpiMerge {
    static constexpr bool PERM = true; static constexpr bool ROWP = false;
    bf16* O; const bf16* GA; const unsigned char* GB;
    __device__ __forceinline__ void mid(f32x4 (&acc)[2][2][4][2], const Unit& u, int wr, int wc, int fr, int fq) const {
        const int rowb = u.pm * 256 + wr * 64 + fr; const int col0 = u.pn * 256 + 64 * wc + 8 * fq;
#pragma unroll
        for (int ai = 0; ai < 2; ++ai)
#pragma unroll
            for (int m = 0; m < 4; ++m) { const size_t ro = (size_t)(rowb + ai * 128 + m * 16) * DM + col0;
#pragma unroll
                for (int bj = 0; bj < 2; ++bj) { float rho[8]; unpack8(*(const u32x4*)(GA + ro + 32 * bj), rho);
#pragma unroll
                    for (int e = 0; e < 4; ++e) { acc[ai][bj][m][0][e] *= rho[e]; acc[ai][bj][m][1][e] *= rho[4 + e]; } } }
    }
    __device__ __forceinline__ void operator()(const f32x4 (&acc)[2][2][4][2], const Unit& u, int wr, int wc, int fr, int fq) const {
        const int rowb = u.pm * 256 + wr * 64 + fr; const int col0 = u.pn * 256 + 64 * wc + 8 * fq;
#pragma unroll
        for (int ai = 0; ai < 2; ++ai)
#pragma unroll
            for (int m = 0; m < 4; ++m) { const size_t ro = (size_t)(rowb + ai * 128 + m * 16) * DM + col0;
#pragma unroll
                for (int bj = 0; bj < 2; ++bj) { float gb[8]; unpack8u(*(const u32x2*)(GB + ro + 32 * bj), gb); float v[8];
#pragma unroll
                    for (int e = 0; e < 4; ++e) { v[e] = acc[ai][bj][m][0][e] * gb[e]; v[4 + e] = acc[ai][bj][m][1][e] * gb[4 + e]; }
                    u32x4 w; w.x = pk2(v[0], v[1]); w.y = pk2(v[2], v[3]); w.z = pk2(v[4], v[5]); w.w = pk2(v[6], v[7]);
                    *(u32x4*)(O + ro + 32 * bj) = w; } }
    }
};
template <int MAP  > __device__ __forceinline__ int dst_row(int n) {
    if (MAP == 1) {
        if (n < 7680) return n; if (n < 7696) return n + 4096;
        const int half = n >= 9744 ? 1 : 0, j = n - (half ? 9744 : 7696); return 7680 + 256 * (j >> 7) + 64 * ((j >> 5) & 3) + 32 * half + (j & 31); }
    if (MAP == 2) { const int half = n >= DFF ? 1 : 0, j = n - half * DFF; return 256 * (j >> 7) + 64 * ((j >> 5) & 3) + 32 * half + (j & 31); }
    return n;
}
template <int MAP> __device__ __forceinline__ void transpose_item(const float* W, int K, int N, bf16* WT, LAS float* scr, int item, int lane) {
    const int nblk = (N + 31) / 32, kb = item / nblk, nb = item % nblk, k0 = 64 * kb, n0 = 32 * nb;
    const int nn = n0 + (lane & 31); const bool ok = nn < N;
    float v[32];
    const float* wp = W + (size_t)(k0 + (lane >> 5)) * N + nn;
#pragma unroll
    for (int i = 0; i < 32; ++i) v[i] = ok ? wp[(size_t)(2 * i) * N] : 0.f;
#pragma unroll
    for (int i = 0; i < 32; ++i) scr[(2 * i + (lane >> 5)) * 33 + (lane & 31)] = v[i];
    asm volatile("s_waitcnt lgkmcnt(0)" ::: "memory");
    const int c = lane & 7;
#pragma unroll
    for (int j = 0; j < 4; ++j) { const int n = (lane >> 3) + 8 * j; const LAS float* s = scr + (8 * c) * 33 + n;
        u32x4 o; o.x = pk2(s[0 * 33], s[1 * 33]); o.y = pk2(s[2 * 33], s[3 * 33]); o.z = pk2(s[4 * 33], s[5 * 33]); o.w = pk2(s[6 * 33], s[7 * 33]);
        if (n0 + n < N) *(u32x4*)(WT + (size_t)dst_row<MAP>(n0 + n) * K + k0 + 8 * c) = o; }
    asm volatile("s_waitcnt lgkmcnt(0)" ::: "memory");
}

#define GAS __attribute__((address_space(1)))
#define XB_TMO      128
#define XB_XCNT(j)  (256  + 64 * (j))
#define XB_XSUB(j)  (1280 + 64 * (j))
#define XB_XGEN(j)  (2304 + 64 * (j))
#define XB_TOP      3328
#define XB_TOPGEN   3392
#define XCD_BAR_WORDS 3456
#define XB_SPIN_CAP (1u << 18)
__device__ __forceinline__ unsigned xb_ld(unsigned* p)              { return __hip_atomic_load(p, __ATOMIC_RELAXED, __HIP_MEMORY_SCOPE_AGENT); }
__device__ __forceinline__ unsigned xb_add(unsigned* p, unsigned v) { return __hip_atomic_fetch_add(p, v, __ATOMIC_RELAXED, __HIP_MEMORY_SCOPE_AGENT); }
__device__ __forceinline__ unsigned xb_xcc_id() { return (unsigned)__builtin_amdgcn_s_getreg((3 << 11) | 20) & 0xFu; }
#define XB_SPIN(cond, bar) do { unsigned _sp = 0; while (cond) { __builtin_amdgcn_s_sleep(1); \
    if ((++_sp & 255u) == 0u) { if (xb_ld(&(bar)[XB_TMO])) break; if (_sp > XB_SPIN_CAP) { atomicAdd(&(bar)[XB_TMO], 1u); break; } } } } while (0)
struct XcdBarrier { unsigned* bar; unsigned x; volatile LAS unsigned* st; };
__device__ __forceinline__ XcdBarrier xcd_barrier_post(unsigned* bar, volatile LAS unsigned* st) {
    XcdBarrier b; b.bar = bar; b.x = xb_xcc_id(); b.st = st;
    if (threadIdx.x == 0) (void)xb_add(&bar[XB_XCNT(b.x)], 1u);
    return b;
}
__device__ __forceinline__ void xcd_barrier_complete(unsigned* bar, unsigned x, unsigned& nloc, unsigned& nx) {
    const unsigned G = gridDim.x * gridDim.y * gridDim.z;
    unsigned sum, cnt, mine, sp = 0u;
    for (;;) {
        sum = 0u; cnt = 0u; mine = 0u;
#pragma unroll
        for (unsigned j = 0; j < 16; ++j) { const unsigned c = xb_ld(&bar[XB_XCNT(j)]); sum += c; cnt += (c > 0u) ? 1u : 0u; mine = (j == x) ? c : mine; }
        if (sum == G) break;
        __builtin_amdgcn_s_sleep(1);
        if ((++sp & 255u) == 0u) { if (xb_ld(&bar[XB_TMO])) break; if (sp > XB_SPIN_CAP) { atomicAdd(&bar[XB_TMO], 1u); break; } }
    }
    nloc = mine > 0u ? mine : 1u; nx = cnt > 0u ? cnt : 1u;
}
__device__ __forceinline__ void xcd_barrier(const XcdBarrier& b) {
    asm volatile("s_waitcnt vmcnt(0)" ::: "memory");
    __syncthreads();
    if (threadIdx.x == 0) {
        unsigned* bar = b.bar;
        __builtin_amdgcn_s_waitcnt(0);
        unsigned nloc = b.st[0], nx = b.st[1];
        if (nloc == 0u) { xcd_barrier_complete(bar, b.x, nloc, nx); b.st[0] = nloc; b.st[1] = nx; }
        const unsigned old = xb_add(&bar[XB_XSUB(b.x)], 1u);
        const unsigned gen = old / nloc;
        if (old + 1u == (gen + 1u) * nloc) {
            __builtin_amdgcn_fence(__ATOMIC_RELEASE, "agent");
            asm volatile("s_waitcnt vmcnt(0)" ::: "memory");
            const unsigned og = xb_add(&bar[XB_TOP], 1u);
            const unsigned tg = og / nx;
            if (og + 1u == (tg + 1u) * nx) xb_add(&bar[XB_TOPGEN], 1u);
            else XB_SPIN(xb_ld(&bar[XB_TOPGEN]) == tg, bar);
            __builtin_amdgcn_fence(__ATOMIC_ACQUIRE, "agent");
            asm volatile("s_waitcnt vmcnt(0)" ::: "memory");
            xb_add(&bar[XB_XGEN(b.x)], 1u);
            asm volatile("s_waitcnt vmcnt(0)" ::: "memory");
        } else {
            XB_SPIN(xb_ld(&bar[XB_XGEN(b.x)]) == gen, bar);
            asm volatile("buffer_inv sc0\n\ts_waitcnt vmcnt(0)" ::: "memory");
        }
    }
    __syncthreads();
}

struct Args {
    const float* in[21]; float* out; unsigned char* ws; int ph_lo, ph_hi;
};

__global__ void __launch_bounds__(NT_BLK, 2) fwd_kernel(Args a) {
    extern __shared__ __attribute__((aligned(16))) unsigned char lds_raw[];
    LAS unsigned char* lds = (LAS unsigned char*)lds_raw;
    volatile LAS unsigned* bst = (volatile LAS unsigned*)((LAS unsigned char*)lds_raw + (LDS_BYTES - 16));
    if (threadIdx.x < 2) bst[threadIdx.x] = 0u;
    __syncthreads();
    XcdBarrier xbar = xcd_barrier_post((unsigned*)a.ws, bst);
    const int tid = threadIdx.x, lane = tid & 63, wave = __builtin_amdgcn_readfirstlane(tid >> 6);
    const int G = gridDim.x, bx = blockIdx.x;
    const int gw = bx * NWAVES + wave, NGW = G * NWAVES;
    unsigned char* ws = a.ws;
    const float* x = a.in[0]; const float* cvec = a.in[1]; const float* relb = a.in[2]; const float* w_ada = a.in[3]; const float* b_ada = a.in[4];
    const float* g1 = a.in[5]; const float* w_in = a.in[6]; const float* qg = a.in[7]; const float* kg = a.in[8]; const float* sinks = a.in[9];
    const float* wgk = a.in[10]; const float* bgk = a.in[11]; const float* glag = a.in[12]; const float* wba = a.in[13]; const float* wbg = a.in[14];
    const float* wout = a.in[15]; const float* g2 = a.in[16]; const float* wup = a.in[17]; const float* convw = a.in[18]; const float* convb = a.in[19]; const float* wdn = a.in[20];
    float* out = a.out;
    float* MODP = (float*)(ws + WS_MODP2); float* MODF = (float*)(ws + WS_MODF);
    bf16* WIN_T = (bf16*)(ws + WS_WIN); bf16* WBA_T = (bf16*)(ws + WS_WBA); bf16* WBG_T = (bf16*)(ws + WS_WBG); bf16* WOUT_T = (bf16*)(ws + WS_WOUT);
    bf16* WUP_T = (bf16*)(ws + WS_WUP); bf16* WDN_T = (bf16*)(ws + WS_WDN);
    bf16* XN = (bf16*)(ws + WS_XN); bf16* OB = (bf16*)(ws + WS_O); bf16* YATT = (bf16*)(ws + WS_YATT);
    float* GLR = (float*)(ws + WS_GLR);
    bf16* AMg = (bf16*)(ws + WS_AM); float* DECg = (float*)(ws + WS_DEC); bf16* QDg = (bf16*)(ws + WS_QD); bf16* KTETg = (bf16*)(ws + WS_KTET);
    bf16* AQ = (bf16*)(ws + WS_AQ); bf16* AK = (bf16*)(ws + WS_AK); bf16* AV = (bf16*)(ws + WS_AV); bf16* GQ = (bf16*)(ws + WS_GQ); bf16* GK = (bf16*)(ws + WS_GK);
    bf16* GV = (bf16*)(ws + WS_GV); bf16* GR = (bf16*)(ws + WS_GR); bf16* GA = (bf16*)out; unsigned char* GB = (unsigned char*)out + (size_t)M * DM * 2;
    bf16* X1B = (bf16*)(ws + WS_X1B); bf16* M1 = (bf16*)(ws + WS_M1); bf16* MRG = (bf16*)(ws + WS_MRG); bf16* ACT = (bf16*)(ws + WS_ACT); float* HALO = (float*)(ws + WS_HALO); float* CWS = (float*)(ws + WS_CWS);
    const int lo = a.ph_lo, hi = a.ph_hi;
#ifndef G2_REPS
#define G2_REPS 1
#endif
#ifndef G1_REPS
#define G1_REPS 1
#endif
#ifndef ATT_REPS
#define ATT_REPS 1
#endif
#ifndef DUP_MASK
#define DUP_MASK 0x0u
#endif
#define REP(k) _Pragma("unroll") for (int rep_ = 0; rep_ <= (int)((DUP_MASK >> (k)) & 1u); ++rep_)
#ifndef PH_MASK
#define PH_MASK 0xFFFFFFFFu
#endif
#define IN(k) (lo <= (k) && (k) < hi && ((PH_MASK >> (k)) & 1u))
#ifndef SEAM_REPS
#define SEAM_REPS 1
#endif
#define SEAM(k) do { if (IN(k) && IN((k) + 1)) { for (int sr_ = 0; sr_ < SEAM_REPS; ++sr_) xcd_barrier(xbar); } } while (0)

    if (IN(0)) REP(0) {
        for (int item = gw; item < ADA_KS * 48; item += NGW) {
            const int ks = item / 48, ng = item % 48, n0 = ng * 256 + lane * 4, k0 = ks * 64;
            f32x4 ac[4] = {{0.f, 0.f, 0.f, 0.f}, {0.f, 0.f, 0.f, 0.f}, {0.f, 0.f, 0.f, 0.f}, {0.f, 0.f, 0.f, 0.f}};
#pragma unroll 8
            for (int kk = 0; kk < 64; ++kk) { const int k = k0 + kk; const f32x4 w = *(const f32x4*)(w_ada + (size_t)k * NMOD + n0);
#pragma unroll
                for (int b = 0; b < 4; ++b) { const float cv = cvec[b * DM + k]; const float cs = cv * sigmoidf_(cv); ac[b] += w * cs; } }
#pragma unroll
            for (int b = 0; b < 4; ++b) *(f32x4*)(MODP + ((size_t)(ks * 4 + b)) * NMOD + n0) = ac[b];
        }
        LAS float* scr = (LAS float*)(lds + wave * 16384);
        constexpr int I_IN = 32 * 369, I_BA = 16 * 64, I_BG = 32 * 64, I_OUT = 32 * 64, I_DN = 88 * 64;
        for (int it = gw; it < I_IN + I_BA + I_BG + I_OUT + I_DN; it += NGW) {
            int r = it;
            if (r < I_IN) { transpose_item<1>(w_in, DM, D_IN, WIN_T, scr, r, lane); continue; } r -= I_IN;
            if (r < I_BA) { transpose_item<0>(wba, 1024, DM, WBA_T, scr, r, lane); continue; } r -= I_BA;
            if (r < I_BG) { transpose_item<0>(wbg, DM, DM, WBG_T, scr, r, lane); continue; } r -= I_BG;
            if (r < I_OUT) { transpose_item<0>(wout, DM, DM, WOUT_T, scr, r, lane); continue; } r -= I_OUT;
            transpose_item<0>(wdn, DFF, DM, WDN_T, scr, r, lane);
        }
        for (int i = bx * NT_BLK + tid; i < 240 * 256; i += G * NT_BLK) ((u32x4*)(WIN_T + (size_t)11792 * DM))[i] = (u32x4){0u, 0u, 0u, 0u};
    }
    SEAM(0);

    if (IN(1)) REP(1) {
        { const int per = (4 * NMOD) / G; for (int i = tid; i < per; i += NT_BLK) { const int idx = bx * per + i; const int b = idx / NMOD, n = idx % NMOD; float s = b_ada[n];
#pragma unroll
            for (int ks = 0; ks < ADA_KS; ++ks) s += MODP[((size_t)(ks * 4 + b)) * NMOD + n];
            MODF[idx] = s; } }
        LAS float* sA = (LAS float*)lds; LAS float* sB = sA + DM;
        const int rows_per = M / G; const int b = (bx * rows_per) >> 12;
        for (int k = 4 * tid; k < DM; k += 4 * NT_BLK) { f32x4 sh = *(const f32x4*)(b_ada + k), sc = *(const f32x4*)(b_ada + DM + k);
#pragma unroll 16
            for (int ks = 0; ks < ADA_KS; ++ks) { sh += *(const f32x4*)(MODP + ((size_t)(ks * 4 + b)) * NMOD + k); sc += *(const f32x4*)(MODP + ((size_t)(ks * 4 + b)) * NMOD + DM + k); }
            *(LAS f32x4*)(sA + k) = *(const f32x4*)(g1 + k) * (1.f + sc); *(LAS f32x4*)(sB + k) = sh; }
        __syncthreads();
        for (int r = wave; r < rows_per; r += 2 * NWAVES) {
            const size_t row0 = (size_t)bx * rows_per + r, row1 = row0 + NWAVES;
            const f32x4* xr0 = (const f32x4*)(x + row0 * DM) + lane; const f32x4* xr1 = (const f32x4*)(x + row1 * DM) + lane; f32x4 v0[8], v1[8];
#pragma unroll
            for (int j = 0; j < 8; ++j) { v0[j] = xr0[64 * j]; v1[j] = xr1[64 * j]; }
            float ss0 = 0.f, ss1 = 0.f;
#pragma unroll
            for (int j = 0; j < 8; ++j) { ss0 += (v0[j][0] * v0[j][0] + v0[j][1] * v0[j][1]) + (v0[j][2] * v0[j][2] + v0[j][3] * v0[j][3]);
                                          ss1 += (v1[j][0] * v1[j][0] + v1[j][1] * v1[j][1]) + (v1[j][2] * v1[j][2] + v1[j][3] * v1[j][3]); }
            const float rstd0 = 1.0f / sqrtf(wave_sum(ss0) * (1.f / DM) + EPS), rstd1 = 1.0f / sqrtf(wave_sum(ss1) * (1.f / DM) + EPS);
            u32x2* o80 = (u32x2*)(XN + row0 * DM) + lane; u32x2* o81 = (u32x2*)(XN + row1 * DM) + lane;
#pragma unroll
            for (int j = 0; j < 8; ++j) { const int k = 4 * lane + 256 * j; const f32x4 A4 = *(const LAS f32x4*)(sA + k), B4 = *(const LAS f32x4*)(sB + k);
                const f32x4 h0 = v0[j] * rstd0 * A4 + B4, h1 = v1[j] * rstd1 * A4 + B4;
                u32x2 w0, w1; w0.x = pk2(h0[0], h0[1]); w0.y = pk2(h0[2], h0[3]); w1.x = pk2(h1[0], h1[1]); w1.y = pk2(h1[2], h1[3]); o80[64 * j] = w0; o81[64 * j] = w1; }
        }
        __syncthreads();
    }
    SEAM(1);

    if (IN(2)) REP(2) {
        pg8::Gemm g{XN, WIN_T, M, NIN_PAD, DM}; pg8::StaticOrder S; S.init(M, NIN_PAD, G, bx, P2_WGM);
        EpiInProj E{AQ, AK, AV, GQ, GK, GV, GR, GA, GB, GLR, qg, kg};
        { const int nlong = ((M / 256) * (NIN_PAD / 256)) % G; const int nshort = G - nlong;
          if (nlong > 0 && bx >= nlong) { LAS float* scr = (LAS float*)(lds + wave * 16384); constexpr int I_UP = 32 * 352;
              for (int it = (bx - nlong) * NWAVES + wave; it < I_UP; it += nshort * NWAVES) transpose_item<2>(wup, DM, NUP, WUP_T, scr, it, lane); }
          else if (nlong == 0) { LAS float* scr = (LAS float*)(lds + wave * 16384); constexpr int I_UP = 32 * 352;
              for (int it = gw; it < I_UP; it += NGW) transpose_item<2>(wup, DM, NUP, WUP_T, scr, it, lane); } }
            __syncthreads();
        pg8::gemm_phase<EpiInProj, pg8::StaticOrder, true, PG8_SP2V>(lds, g, S, E);
    }
    SEAM(2);

    if (IN(3)) REP(3) {
        typedef short bf16x8 __attribute__((ext_vector_type(8)));
        const int team = wave >> 2, tw = wave & 3, ttid = tid & 255;
        LAS bf16* Ks = (LAS bf16*)(lds + team * 72704);
        LAS bf16* VT = Ks + 256 * 72;
        LAS float* blut = (LAS float*)(VT + 64 * 264);
        const int l15 = lane & 15, l4 = lane >> 4;
        for (int arep_ = 0; arep_ < ATT_REPS; ++arep_) for (int unit0 = bx; unit0 < 256; unit0 += G) {
            const int unit = unit0 + 256 * team;
            const int nb = unit & 31, hk = (unit >> 5) & 3, b = unit >> 7;
            const long tokb = (long)b * SEQ + nb * 128 - 128;
            const int gq = tw, hq = 4 * hk + gq; const float sink = sinks[hq];
            const bf16* qbase = AQ + ((size_t)b * SEQ + nb * 128 + l15) * 1024 + hq * 64 + 8 * l4;
            bf16x8 qn0 = *(const bf16x8*)qbase, qn1 = *(const bf16x8*)(qbase + 32);
            __syncthreads();
#pragma unroll
            for (int i = 0; i < 8; ++i) { const int p = ttid + 256 * i, key = p >> 3, ch = p & 7; const bool ok = (nb > 0) || (key >= 128);
                const size_t tk = (size_t)(ok ? tokb + key : tokb + key + 128);
                const u32x4 z4 = (u32x4){0u, 0u, 0u, 0u}; const u32x4 kl = *(const u32x4*)(AK + tk * 256 + hk * 64 + ch * 8), vl = *(const u32x4*)(AV + tk * 256 + hk * 64 + ch * 8);
                const u32x4 kv = ok ? kl : z4, vv = ok ? vl : z4;
                *(LAS u32x4*)(Ks + key * 72 + ch * 8) = kv;
                LAS bf16* vt = VT + (ch * 8) * 264 + ((key + 16 * (ch >> 1)) & 255);
                vt[0 * 264] = (bf16)(vv.x & 0xffffu); vt[1 * 264] = (bf16)(vv.x >> 16); vt[2 * 264] = (bf16)(vv.y & 0xffffu); vt[3 * 264] = (bf16)(vv.y >> 16);
                vt[4 * 264] = (bf16)(vv.z & 0xffffu); vt[5 * 264] = (bf16)(vv.z >> 16); vt[6 * 264] = (bf16)(vv.w & 0xffffu); vt[7 * 264] = (bf16)(vv.w >> 16); }
#pragma unroll
            for (int e = 0; e < 2; ++e) { const int idx = ttid + 256 * e; const int g_ = idx >> 7, d = idx & 127; int bk;
              if (d < 16) bk = d; else { const float v = logf((float)d / 16.0f) / 2.0794415416798357f * 16.0f; bk = 16 + (int)v; if (bk > 31) bk = 31; }
              blut[idx] = relb[bk * 16 + 4 * hk + g_]; }
            __syncthreads();
            f32x4 bv[9];
#pragma unroll
            for (int t = 0; t < 9; ++t)
#pragma unroll
                for (int r = 0; r < 4; ++r) { const int dist = l15 - 4 * l4 - r + 128 - 16 * t; bv[t][r] = (dist >= 0 && dist < 128) ? blut[gq * 128 + (dist & 127)] : -1e30f; }
#pragma unroll 1
            for (int i = 0; i < 8; ++i) {
                const int q0 = 16 * i, kt0 = i, iq = q0 + l15;
                const size_t tokq = (size_t)b * SEQ + nb * 128 + iq;
                const bf16x8 qf0 = qn0, qf1 = qn1;
                { const int in_ = (i < 7) ? i + 1 : i; qn0 = *(const bf16x8*)(qbase + (size_t)in_ * 16 * 1024); qn1 = *(const bf16x8*)(qbase + (size_t)in_ * 16 * 1024 + 32); }
                f32x4 sc[9];
#pragma unroll
                for (int t = 0; t < 9; ++t) { const LAS bf16* kp = Ks + (16 * (kt0 + t) + l15) * 72 + 8 * l4;
                    const bf16x8 a0 = *(const LAS bf16x8*)kp, a1 = *(const LAS bf16x8*)(kp + 32);
                    sc[t] = __builtin_amdgcn_mfma_f32_16x16x32_bf16(a1, qf1, __builtin_amdgcn_mfma_f32_16x16x32_bf16(a0, qf0, bv[t], 0, 0, 0), 0, 0, 0); }
                if (nb == 0) {
#pragma unroll
                    for (int t = 0; t < 9; ++t) if (kt0 + t < 8) {
#pragma unroll
                        for (int r = 0; r < 4; ++r) sc[t][r] = -1e30f; } }
                float mx = sink;
#pragma unroll
                for (int t = 0; t < 9; ++t)
#pragma unroll
                    for (int r = 0; r < 4; ++r) mx = fmaxf(mx, sc[t][r]);
                mx = fmaxf(mx, __shfl_xor(mx, 16)); mx = fmaxf(mx, __shfl_xor(mx, 32));
                const float nmx = -1.4426950408889634f * mx;
                float sum = 0.f;
#pragma unroll
                for (int t = 0; t < 9; ++t)
#pragma unroll
                    for (int r = 0; r < 4; ++r) { const float p = __builtin_amdgcn_exp2f(fmaf(sc[t][r], 1.4426950408889634f, nmx)); sc[t][r] = p; sum += p; }
                sum += __shfl_xor(sum, 16); sum += __shfl_xor(sum, 32);
                const float inv = 1.0f / (sum + __expf(sink - mx));
                f32x4 o[4];
#pragma unroll
                for (int dt = 0; dt < 4; ++dt) o[dt] = (f32x4){0.f, 0.f, 0.f, 0.f};
#pragma unroll
                for (int ks = 0; ks < 5; ++ks) { const int ta = 2 * ks, tb = (2 * ks + 1 < 9) ? 2 * ks + 1 : 2 * ks;
                    u32x4 pw; pw.x = pk2(sc[ta][0], sc[ta][1]); pw.y = pk2(sc[ta][2], sc[ta][3]);
                    if (2 * ks + 1 < 9) { pw.z = pk2(sc[tb][0], sc[tb][1]); pw.w = pk2(sc[tb][2], sc[tb][3]); } else { pw.z = 0u; pw.w = 0u; }
                    const bf16x8 pop = __builtin_bit_cast(bf16x8, pw);
#pragma unroll
                    for (int dt = 0; dt < 4; ++dt) { const LAS bf16* vp = VT + (16 * dt + l15) * 264 + 4 * l4;
                        const u32x2 va = *(const LAS u32x2*)(vp + ((16 * (kt0 + ta + dt)) & 255)), vb = *(const LAS u32x2*)(vp + ((16 * (kt0 + tb + dt)) & 255));
                        const u32x4 vw = (u32x4){va.x, va.y, vb.x, vb.y};
                        o[dt] = __builtin_amdgcn_mfma_f32_16x16x32_bf16(__builtin_bit_cast(bf16x8, vw), pop, o[dt], 0, 0, 0); } }
                bf16* op = YATT + tokq * 1024 + hq * 64 + 4 * l4;
#pragma unroll
                for (int dt = 0; dt < 4; ++dt) { u32x2 w; w.x = pk2(o[dt][0] * inv, o[dt][1] * inv); w.y = pk2(o[dt][2] * inv, o[dt][3] * inv); *(u32x2*)(op + 16 * dt) = w; }
            }
        }
        __syncthreads();
        {
            typedef short bf16x8 __attribute__((ext_vector_type(8)));
            LAS float* glrs = (LAS float*)lds;
            LAS float* tots = glrs + 1024;
            LAS float* Gs = tots + 512 + 256;
            LAS bf16* QDs = (LAS bf16*)(Gs + 64 * 256);
            LAS bf16* KIs = QDs + 64 * 264;
            const int dk = tid & 255, half = tid >> 8, l15 = lane & 15, l4 = lane >> 4, cg8 = (tid & 31) * 8, r0 = tid >> 5;
            typedef short bf16x4_t __attribute__((ext_vector_type(4)));
            bf16x4_t wh[2], wl[2]; float bg = 0.f; int hcur = -1;
            for (int grep_ = 0; grep_ < G1_REPS; ++grep_) {
            float ng0 = GLR[(size_t)(((bx >> 6) >> 2) * SEQ + (bx & 63) * 64) * 16 + tid], ng1 = GLR[(size_t)(((bx >> 6) >> 2) * SEQ + (bx & 63) * 64) * 16 + 512 + tid];
            for (int u = bx; u < 1024; u += G) {
                const int pair = u >> 6, n = u & 63, b = pair >> 2, h = pair & 3; const size_t tokc = (size_t)b * SEQ + n * 64;
                __syncthreads();
                u32x4 q8[4], k8[4];
#pragma unroll
                for (int i = 0; i < 4; ++i) { const size_t go = (tokc + r0 + 16 * i) * 1024 + h * 256 + cg8; q8[i] = *(const u32x4*)(GQ + go); k8[i] = *(const u32x4*)(GK + go); }
                glrs[tid] = ng0; glrs[tid + 512] = ng1;
                { const int un = (u + G < 1024) ? u + G : u; const size_t tn = (size_t)((un >> 6) >> 2) * SEQ + (size_t)(un & 63) * 64; ng0 = GLR[tn * 16 + tid]; ng1 = GLR[tn * 16 + 512 + tid]; }
                if (h != hcur) { hcur = h;
#pragma unroll
                for (int jt = 0; jt < 2; ++jt) { const int dkc = h * 256 + 32 * wave + 16 * jt + l15; float wv[4];
#pragma unroll
                    for (int e = 0; e < 4; ++e) wv[e] = wgk[(4 * l4 + e) * 1024 + dkc] * 1.4426950408889634f;
                    const unsigned h01 = pk2(wv[0], wv[1]), h23 = pk2(wv[2], wv[3]);
                    const unsigned l01 = pk2(wv[0] - bf2f(h01 & 0xffffu), wv[1] - bf2f(h01 >> 16)), l23 = pk2(wv[2] - bf2f(h23 & 0xffffu), wv[3] - bf2f(h23 >> 16));
                    wh[jt] = __builtin_bit_cast(bf16x4_t, (u32x2){h01, h23}); wl[jt] = __builtin_bit_cast(bf16x4_t, (u32x2){l01, l23}); }
                bg = bgk[h * 256 + dk] * 1.4426950408889634f; }
                __syncthreads();
#pragma unroll
                for (int tt = 0; tt < 4; ++tt) { const f32x4 g4 = *(const LAS f32x4*)(glrs + (16 * tt + l15) * 16 + 4 * l4);
                    const unsigned h01 = pk2(g4[0], g4[1]), h23 = pk2(g4[2], g4[3]);
                    const unsigned l01 = pk2(g4[0] - bf2f(h01 & 0xffffu), g4[1] - bf2f(h01 >> 16)), l23 = pk2(g4[2] - bf2f(h23 & 0xffffu), g4[3] - bf2f(h23 >> 16));
                    const bf16x4_t gh = __builtin_bit_cast(bf16x4_t, (u32x2){h01, h23}), glo = __builtin_bit_cast(bf16x4_t, (u32x2){l01, l23});
#pragma unroll
                    for (int jt = 0; jt < 2; ++jt) { f32x4 zt = (f32x4){0.f, 0.f, 0.f, 0.f};
                        zt = __builtin_amdgcn_mfma_f32_16x16x16bf16_1k(gh, wh[jt], zt, 0, 0, 0); zt = __builtin_amdgcn_mfma_f32_16x16x16bf16_1k(gh, wl[jt], zt, 0, 0, 0); zt = __builtin_amdgcn_mfma_f32_16x16x16bf16_1k(glo, wh[jt], zt, 0, 0, 0);
                        LAS float* zp = Gs + (16 * tt + 4 * l4) * 256 + 32 * wave + 16 * jt + l15;
                        zp[0] = zt[0]; zp[256] = zt[1]; zp[512] = zt[2]; zp[768] = zt[3]; } }
                __syncthreads();
                float gl[32]; float run = 0.f;
#pragma unroll
                for (int i = 0; i < 32; ++i) { const float z = bg + Gs[(half * 32 + i) * 256 + dk];
                    const float ls = fminf(z, 0.f) - __builtin_amdgcn_logf(1.0f + __builtin_amdgcn_exp2f(-fabsf(z))); run += ls * 0.0625f; gl[i] = run; }
                tots[half * 256 + dk] = run;
                __syncthreads();
                const float t0 = tots[dk], t1 = tots[256 + dk]; const float glast = t0 + t1, off = half ? t0 : 0.f;
#pragma unroll
                for (int i = 0; i < 32; ++i) Gs[(half * 32 + i) * 256 + dk] = gl[i] + off;
                const float eglast = __builtin_amdgcn_exp2f(glast);
                if (half == 0) DECg[(size_t)u * 256 + dk] = eglast;
                __syncthreads();
#pragma unroll
                for (int i = 0; i < 4; ++i) { const int row = r0 + 16 * i; const f32x4 ga = *(const LAS f32x4*)(Gs + row * 256 + cg8), gb = *(const LAS f32x4*)(Gs + row * 256 + cg8 + 4);
                    float qf[8], kf[8]; unpack8(q8[i], qf); unpack8(k8[i], kf); float qd[8], ki[8];
#pragma unroll
                    for (int e = 0; e < 4; ++e) { const float ea = __builtin_amdgcn_exp2f(ga[e]), eb = __builtin_amdgcn_exp2f(gb[e]); qd[e] = qf[e] * ea; ki[e] = kf[e] * __builtin_amdgcn_rcpf(ea); qd[4 + e] = qf[4 + e] * eb; ki[4 + e] = kf[4 + e] * __builtin_amdgcn_rcpf(eb); }
                    u32x4 qw, kw; qw.x = pk2(qd[0], qd[1]); qw.y = pk2(qd[2], qd[3]); qw.z = pk2(qd[4], qd[5]); qw.w = pk2(qd[6], qd[7]);
                    kw.x = pk2(ki[0], ki[1]); kw.y = pk2(ki[2], ki[3]); kw.z = pk2(ki[4], ki[5]); kw.w = pk2(ki[6], ki[7]);
                    *(LAS u32x4*)(QDs + row * 264 + cg8) = qw; *(LAS u32x4*)(KIs + row * 264 + cg8) = kw;
                    *(u32x4*)(QDg + ((size_t)u * 64 + row) * 256 + cg8) = qw; }
                __syncthreads();
                {
                    unsigned ktp[16];
#pragma unroll
                    for (int i = 0; i < 32; ++i) { const float kte = bf2f(KIs[(half * 32 + i) * 264 + dk]) * eglast;
                        if (i & 1) ktp[i >> 1] |= f2bf(kte) << 16; else ktp[i >> 1] = f2bf(kte); }
                    bf16* ktdst = KTETg + (size_t)u * 16384 + (size_t)((dk >> 5) * 8 + 4 * half) * 256 + (dk & 31) * 8;
#pragma unroll
                    for (int j = 0; j < 4; ++j) *(u32x4*)(ktdst + 256 * j) = (u32x4){ktp[4 * j], ktp[4 * j + 1], ktp[4 * j + 2], ktp[4 * j + 3]};
                }
                const int ti = wave >> 1;
#pragma unroll
                for (int tjj = 0; tjj < 2; ++tjj) { const int tj = 2 * (wave & 1) + tjj; f32x4 acc = (f32x4){0.f, 0.f, 0.f, 0.f};
                    if (tj <= ti) {
#pragma unroll
                        for (int s8 = 0; s8 < 8; ++s8) { const bf16x8 aop = *(const LAS bf16x8*)(KIs + (16 * tj + l15) * 264 + 32 * s8 + 8 * l4), bop = *(const LAS bf16x8*)(QDs + (16 * ti + l15) * 264 + 32 * s8 + 8 * l4);
                            acc = __builtin_amdgcn_mfma_f32_16x16x32_bf16(aop, bop, acc, 0, 0, 0); } }
                    const int ii = 16 * ti + l15, j0 = 16 * tj + 4 * l4;
                    u32x2 w; w.x = pk2(j0 <= ii ? acc[0] : 0.f, j0 + 1 <= ii ? acc[1] : 0.f); w.y = pk2(j0 + 2 <= ii ? acc[2] : 0.f, j0 + 3 <= ii ? acc[3] : 0.f);
                    *(u32x2*)(AMg + ((size_t)u * 64 + ii) * 64 + j0) = w; }
            }
            }
            __syncthreads();
        }
    }
    SEAM(3);

    if (IN(4)) for (int g2rep_ = 0; g2rep_ < G2_REPS; ++g2rep_) {
        typedef short bf16x8 __attribute__((ext_vector_type(8)));
        typedef float f32x16 __attribute__((ext_vector_type(16)));
        LAS bf16* QDb = (LAS bf16*)lds;
        LAS bf16* AMs = QDb + 3 * 64 * 256;
        LAS bf16* VTs = AMs + 2 * 64 * 72;
        LAS bf16* SbT = VTs + 2 * 32 * 72;
        LAS float* DECs = (LAS float*)(SbT + 2 * 32 * 264);
        const int l15 = lane & 15, l4 = lane >> 4, l31 = lane & 31, l5 = lane >> 5;
        unsigned qsrc[8];
#pragma unroll
        for (int j = 0; j < 8; ++j) { const int r = 16 * (wave & 3) + 2 * j + (lane >> 5); qsrc[j] = (unsigned)(r * 256 + (((lane & 31) ^ (r & 15)) * 8)) * 2u; }
        const unsigned qdst0 = (unsigned)(uintptr_t)QDb + (unsigned)(wave & 3) * 8192u;
        for (int task = bx; task < 256; task += G) {
            const int pair = (task & 7) * 2 + ((task >> 3) >> 4), slice = (task >> 3) & 15;
            const int b = pair >> 2, h = pair & 3; const size_t u0 = (size_t)pair * 64;
            __syncthreads();
            for (int i = tid; i < 1056; i += NT_BLK) ((LAS u32x4*)SbT)[i] = (u32x4){0u, 0u, 0u, 0u};
            int qcur = 0;
#define G2_GLDS(gsrc, ldsdst) do { unsigned keep_; asm volatile("s_mov_b32 %0, m0\n\ts_mov_b32 m0, %2\n\ts_nop 0\n\tglobal_load_lds_dwordx4 %1, off\n\ts_mov_b32 m0, %0" : "=&s"(keep_) : "v"(gsrc), "s"(ldsdst) : "memory"); } while (0)
#define G2_DMA_Q(nn, buf) do { const char* qb_ = (const char*)(QDg + (u0 + (nn)) * 16384); const unsigned d_ = (unsigned)__builtin_amdgcn_readfirstlane((int)(qdst0 + (unsigned)(buf) * 32768u)); \
            _Pragma("unroll") for (int j_ = 0; j_ < 8; ++j_) G2_GLDS(qb_ + qsrc[j_], d_ + (unsigned)j_ * 1024u); } while (0)
#define G2_DMA_NEXT(n) do { const int nq_ = ((n) + 2 < 64) ? (n) + 2 : (n); const int qn_ = qcur ? qcur - 1 : 2; G2_DMA_Q(nq_, qn_); } while (0)
            if (wave < 4) {
                const int ti = wave;
                u32x4 ra0A, ra1A, rvA; float rdA;
                u32x4 ra0B, ra1B, rvB; float rdB;
#define G2_LOADO(nn, ra0, ra1, rv, rd) do { const size_t u_ = u0 + (nn); const size_t tokc_ = (size_t)b * SEQ + (size_t)(nn) * 64; \
                ra0 = *(const u32x4*)(AMg + u_ * 4096 + (size_t)tid * 8); ra1 = *(const u32x4*)(AMg + u_ * 4096 + (size_t)(tid + 256) * 8); \
                rv = *(const u32x4*)(GV + (tokc_ + (tid >> 2)) * 2048 + h * 512 + slice * 32 + (tid & 3) * 8); rd = DECg[u_ * 256 + tid]; } while (0)
#define G2_STEP_O(n, par, ra0, ra1, rv, rd) do { \
                    LAS bf16* AMn = AMs + (par) * 64 * 72; LAS bf16* VTn = VTs + (par) * 32 * 72; LAS float* DECn = DECs + (par) * 256; \
                    asm volatile("s_waitcnt vmcnt(6)" ::: "memory");        \
                    *(LAS u32x4*)(AMn + (tid >> 3) * 72 + (tid & 7) * 8) = ra0; *(LAS u32x4*)(AMn + ((tid >> 3) + 32) * 72 + (tid & 7) * 8) = ra1; \
                    { LAS bf16* vt = VTn + ((tid & 3) * 8) * 72 + (tid >> 2); \
                      vt[0 * 72] = (bf16)(rv.x & 0xffffu); vt[1 * 72] = (bf16)(rv.x >> 16); vt[2 * 72] = (bf16)(rv.y & 0xffffu); vt[3 * 72] = (bf16)(rv.y >> 16); \
                      vt[4 * 72] = (bf16)(rv.z & 0xffffu); vt[5 * 72] = (bf16)(rv.z >> 16); vt[6 * 72] = (bf16)(rv.w & 0xffffu); vt[7 * 72] = (bf16)(rv.w >> 16); \
                      DECn[tid] = rd; } \
                    __syncthreads(); \
                    { const int nl_ = ((n) + 2 < 64) ? (n) + 2 : (n); G2_LOADO(nl_, ra0, ra1, rv, rd); } \
                    { const LAS bf16* Sb = SbT + (par) * 32 * 264; const LAS bf16* Qb = QDb + qcur * 16384; \
                      f32x4 acc0 = (f32x4){0.f, 0.f, 0.f, 0.f}, acc1 = acc0; \
                      _Pragma("unroll") for (int s8 = 0; s8 < 8; ++s8) { const bf16x8 bop = *(const LAS bf16x8*)(Qb + (16 * ti + l15) * 256 + (((4 * s8 + l4) ^ l15) * 8)); \
                          const bf16x8 aop0 = *(const LAS bf16x8*)(Sb + l15 * 264 + 32 * s8 + 8 * l4), aop1 = *(const LAS bf16x8*)(Sb + (16 + l15) * 264 + 32 * s8 + 8 * l4); \
                          acc0 = __builtin_amdgcn_mfma_f32_16x16x32_bf16(aop0, bop, acc0, 0, 0, 0); acc1 = __builtin_amdgcn_mfma_f32_16x16x32_bf16(aop1, bop, acc1, 0, 0, 0); } \
                      _Pragma("unroll") for (int s2 = 0; s2 < 2; ++s2) { const bf16x8 bop = *(const LAS bf16x8*)(AMn + (16 * ti + l15) * 72 + 32 * s2 + 8 * l4); \
                          const bf16x8 aop0 = *(const LAS bf16x8*)(VTn + l15 * 72 + 32 * s2 + 8 * l4), aop1 = *(const LAS bf16x8*)(VTn + (16 + l15) * 72 + 32 * s2 + 8 * l4); \
                          acc0 = __builtin_amdgcn_mfma_f32_16x16x32_bf16(aop0, bop, acc0, 0, 0, 0); acc1 = __builtin_amdgcn_mfma_f32_16x16x32_bf16(aop1, bop, acc1, 0, 0, 0); } \
                      bf16* op_ = OB + ((size_t)b * SEQ + (size_t)(n) * 64 + 16 * ti + l15) * 2048 + h * 512 + slice * 32 + 4 * l4; \
                      u32x2 w0, w1; w0.x = pk2(acc0[0], acc0[1]); w0.y = pk2(acc0[2], acc0[3]); w1.x = pk2(acc1[0], acc1[1]); w1.y = pk2(acc1[2], acc1[3]); \
                      *(u32x2*)(op_) = w0; *(u32x2*)(op_ + 16) = w1; } \
                    qcur = (qcur == 2) ? 0 : qcur + 1; \
                } while (0)
                G2_LOADO(0, ra0A, ra1A, rvA, rdA); G2_LOADO(1, ra0B, ra1B, rvB, rdB);
                const float dummy0_ = DECg[u0 * 256 + tid], dummy1_ = DECg[u0 * 256 + 256 + tid];
#pragma unroll 1
                for (int n = 0; n < 64; n += 2) {
                    G2_STEP_O(n, 0, ra0A, ra1A, rvA, rdA);
                    G2_STEP_O(n + 1, 1, ra0B, ra1B, rvB, rdB);
                }
                asm volatile("s_waitcnt vmcnt(0)" :: "v"(dummy0_), "v"(dummy1_) : "memory");
#undef G2_STEP_O
#undef G2_LOADO
            } else {
                const int sw = wave - 4;
                f32x16 S0, S1;
#pragma unroll
                for (int r = 0; r < 16; ++r) { S0[r] = 0.f; S1[r] = 0.f; }
                u32x4 rkA[8], rkB[8];
#define G2_LOADK(nn, rk) do { const bf16* kb_ = KTETg + (u0 + (nn)) * 16384 + (size_t)(sw * 4096 + lane * 8); \
                _Pragma("unroll") for (int i_ = 0; i_ < 8; ++i_) rk[i_] = *(const u32x4*)(kb_ + i_ * 512); } while (0)
#define G2_STEP_S(n, par, rk) do { \
                    const LAS bf16* VTn = VTs + (par) * 32 * 72; const LAS float* DECn = DECs + (par) * 256 + 64 * sw + 4 * l5; \
                    asm volatile("s_waitcnt vmcnt(16)" ::: "memory");       \
                    __syncthreads(); \
                    G2_DMA_NEXT(n); \
                    { _Pragma("unroll") for (int g4 = 0; g4 < 4; ++g4) { const f32x4 d0 = *(const LAS f32x4*)(DECn + 8 * g4), d1 = *(const LAS f32x4*)(DECn + 32 + 8 * g4); \
                          S0[4 * g4] *= d0[0]; S0[4 * g4 + 1] *= d0[1]; S0[4 * g4 + 2] *= d0[2]; S0[4 * g4 + 3] *= d0[3]; \
                          S1[4 * g4] *= d1[0]; S1[4 * g4 + 1] *= d1[1]; S1[4 * g4 + 2] *= d1[2]; S1[4 * g4 + 3] *= d1[3]; } \
                      _Pragma("unroll") for (int s4 = 0; s4 < 4; ++s4) { const bf16x8 bop = *(const LAS bf16x8*)(VTn + l31 * 72 + 16 * s4 + 8 * l5); \
                          S0 = __builtin_amdgcn_mfma_f32_32x32x16_bf16(__builtin_bit_cast(bf16x8, rk[s4]), bop, S0, 0, 0, 0); \
                          S1 = __builtin_amdgcn_mfma_f32_32x32x16_bf16(__builtin_bit_cast(bf16x8, rk[4 + s4]), bop, S1, 0, 0, 0); } \
                      LAS bf16* Sn = SbT + (1 - (par)) * 32 * 264 + l31 * 264 + 64 * sw + 4 * l5; \
                      _Pragma("unroll") for (int g4 = 0; g4 < 4; ++g4) { u32x2 w2; w2.x = pk2(S0[4 * g4], S0[4 * g4 + 1]); w2.y = pk2(S0[4 * g4 + 2], S0[4 * g4 + 3]); *(LAS u32x2*)(Sn + 8 * g4) = w2; \
                          u32x2 w3; w3.x = pk2(S1[4 * g4], S1[4 * g4 + 1]); w3.y = pk2(S1[4 * g4 + 2], S1[4 * g4 + 3]); *(LAS u32x2*)(Sn + 32 + 8 * g4) = w3; } } \
                    { const int nl_ = ((n) + 2 < 64) ? (n) + 2 : (n); G2_LOADK(nl_, rk); } \
                    qcur = (qcur == 2) ? 0 : qcur + 1; \
                } while (0)
                G2_LOADK(0, rkA); G2_DMA_Q(0, 0); G2_LOADK(1, rkB); G2_DMA_Q(1, 1);
#pragma unroll 1
                for (int n = 0; n < 64; n += 2) {
                    G2_STEP_S(n, 0, rkA);
                    G2_STEP_S(n + 1, 1, rkB);
                }
                asm volatile("s_waitcnt vmcnt(0)" ::: "memory");
#undef G2_STEP_S
#undef G2_LOADK
            }
#undef G2_DMA_NEXT
#undef G2_DMA_Q
#undef G2_GLDS
        }
        __syncthreads();
    }
    SEAM(4);

    if (IN(5)) {
        const f32x4 ga = *(const f32x4*)(glag + lane * 8), gb2 = *(const f32x4*)(glag + lane * 8 + 4);
        for (int r0 = gw * 4; r0 < M * 4; r0 += NGW * 4) {
            u32x4 ov[4], gv[4];
#pragma unroll
            for (int q = 0; q < 4; ++q) { const size_t off = (size_t)(r0 + q) * 512 + lane * 8; ov[q] = *(const u32x4*)(OB + off); gv[q] = *(const u32x4*)(GR + off); }
#pragma unroll
            for (int q = 0; q < 4; ++q) { const size_t off = (size_t)(r0 + q) * 512 + lane * 8;
                float v[8], gr[8]; unpack8(ov[q], v); unpack8(gv[q], gr);
                float ss = 0.f;
#pragma unroll
                for (int e = 0; e < 8; ++e) ss += v[e] * v[e];
                const float rstd = 1.0f / sqrtf(wave_sum(ss) * (1.f / 512.f) + EPS);
                float y[8];
#pragma unroll
                for (int e = 0; e < 4; ++e) { y[e] = v[e] * rstd * ga[e] * gr[e]; y[4 + e] = v[4 + e] * rstd * gb2[e] * gr[4 + e]; }
                u32x4 w; w.x = pk2(y[0], y[1]); w.y = pk2(y[2], y[3]); w.z = pk2(y[4], y[5]); w.w = pk2(y[6], y[7]);
                *(u32x4*)(OB + off) = w; }
        }
    }
    SEAM(5);

    if (IN(7)) REP(7) {
        pg8::Gemm2 g{YATT, WBA_T, 1024, OB, WBG_T, DM}; pg8::StaticOrder S; S.init(M, DM, G, bx, P7_WGM);
        EpiMerge E{MRG, GA, GB};
        pg8::gemm_phase2<EpiMerge, pg8::StaticOrder>(lds, g, S, E);
    }
    SEAM(7);
    if (IN(8)) REP(8) {
        pg8::Gemm g{MRG, WOUT_T, M, DM, DM}; pg8::StaticOrder S; S.init(M, DM, G, bx, P8_WGM);
        EpiResToBf16 E{x, X1B, MODF + 2 * DM};
        pg8::gemm_phase<EpiResToBf16, pg8::StaticOrder, true, PG8_SP2V>(lds, g, S, E);
    }
    SEAM(8);
    if (IN(9)) REP(9) {
        for (int i = bx * NT_BLK + tid; i < 4 * NUP; i += G * NT_BLK) { const int c = i % NUP; const float sc = (c < DFF) ? -1.4426950408889634f : -0.6931471805599453f;
            CWS[i] = ((i < 3 * NUP) ? convw[i] : convb[c]) * sc; }
        LAS float* sA = (LAS float*)lds; LAS float* sB = sA + DM;
        const int rows_per = M / G; const int b = (bx * rows_per) >> 12;
        for (int k = tid; k < DM; k += NT_BLK) { sA[k] = g2[k] * (1.f + MODF[(size_t)b * NMOD + 4 * DM + k]); sB[k] = MODF[(size_t)b * NMOD + 3 * DM + k]; }
        __syncthreads();
        for (int r = wave; r < rows_per; r += 2 * NWAVES) {
            const size_t row0 = (size_t)bx * rows_per + r, row1 = row0 + NWAVES;
            const u32x4* xr0 = (const u32x4*)(X1B + row0 * DM) + lane; const u32x4* xr1 = (const u32x4*)(X1B + row1 * DM) + lane; u32x4 p0[4], p1[4];
#pragma unroll
            for (int j = 0; j < 4; ++j) { p0[j] = xr0[64 * j]; p1[j] = xr1[64 * j]; }
            float v0[4][8], v1[4][8]; float ss0 = 0.f, ss1 = 0.f;
#pragma unroll
            for (int j = 0; j < 4; ++j) { unpack8(p0[j], v0[j]); unpack8(p1[j], v1[j]);
#pragma unroll
                for (int e = 0; e < 8; ++e) { ss0 += v0[j][e] * v0[j][e]; ss1 += v1[j][e] * v1[j][e]; } }
            const float rstd0 = 1.0f / sqrtf(wave_sum(ss0) * (1.f / DM) + EPS), rstd1 = 1.0f / sqrtf(wave_sum(ss1) * (1.f / DM) + EPS);
            u32x4* o160 = (u32x4*)(XN + row0 * DM) + lane; u32x4* o161 = (u32x4*)(XN + row1 * DM) + lane;
#pragma unroll
            for (int j = 0; j < 4; ++j) { const int k = 8 * lane + 512 * j; const f32x4 A0 = *(const LAS f32x4*)(sA + k), A1 = *(const LAS f32x4*)(sA + k + 4), B0 = *(const LAS f32x4*)(sB + k), B1 = *(const LAS f32x4*)(sB + k + 4);
                float h0[8], h1[8];
#pragma unroll
                for (int e = 0; e < 4; ++e) { h0[e] = v0[j][e] * rstd0 * A0[e] + B0[e]; h0[4 + e] = v0[j][4 + e] * rstd0 * A1[e] + B1[e]; h1[e] = v1[j][e] * rstd1 * A0[e] + B0[e]; h1[4 + e] = v1[j][4 + e] * rstd1 * A1[e] + B1[e]; }
                u32x4 w0, w1; w0.x = pk2(h0[0], h0[1]); w0.y = pk2(h0[2], h0[3]); w0.z = pk2(h0[4], h0[5]); w0.w = pk2(h0[6], h0[7]);
                w1.x = pk2(h1[0], h1[1]); w1.y = pk2(h1[2], h1[3]); w1.z = pk2(h1[4], h1[5]); w1.w = pk2(h1[6], h1[7]); o160[64 * j] = w0; o161[64 * j] = w1; }
        }
        __syncthreads();
    }
    SEAM(9);
    if (IN(10)) REP(10) {
        pg8::Gemm g{XN, WUP_T, M, NUP, DM}; pg8::StaticOrder S; S.init(M, NUP, G, bx, P10_WGM);
        EpiConvGate E{ACT, HALO, CWS, CWS + 3 * NUP, (LAS float*)(lds + 131072)};
        pg8::gemm_phase<EpiConvGate, pg8::StaticOrder, true, PG8_SP2V>(lds, g, S, E);
    }
    SEAM(10);
    if (IN(12)) {
        pg8::Gemm g{ACT, WDN_T, M, DM, DFF}; pg8::StaticOrder S; S.init(M, DM, G, bx, P12_WGM);
        {
            pg8::Unit uu; int pmA = -1, pmB = -1;
            for (int ui = 0; S.next(ui, uu); ++ui) { if (pmA < 0) pmA = uu.pm; else if (uu.pm != pmA && pmB < 0) pmB = uu.pm;
                else if (uu.pm != pmA && uu.pm != pmB) {
                    const int pm = uu.pm; const bool first = (pm & 15) == 0;
                    for (int it = tid; it < DFF / 4; it += NT_BLK) { const int j0 = it * 4; const int uc = 256 * (j0 >> 7) + 64 * ((j0 >> 5) & 3) + (j0 & 31);
                        const float* h0 = HALO + (size_t)(pm * 4) * NUP + uc; const float* hp = HALO + (size_t)((first ? pm : pm - 1) * 4) * NUP + uc; const float pz = first ? 0.f : 1.f;
                        const f32x4 r0a = *(const f32x4*)h0, r0b = *(const f32x4*)(h0 + 32), r1a = *(const f32x4*)(h0 + NUP), r1b = *(const f32x4*)(h0 + NUP + 32);
                        const f32x4 q4a = *(const f32x4*)(hp + 2 * NUP) * pz, q4b = *(const f32x4*)(hp + 2 * NUP + 32) * pz, q5a = *(const f32x4*)(hp + 3 * NUP) * pz, q5b = *(const f32x4*)(hp + 3 * NUP + 32) * pz;
                        const f32x4 w0a = *(const f32x4*)(convw + j0), w1a = *(const f32x4*)(convw + (size_t)NUP + j0), w2a = *(const f32x4*)(convw + 2 * (size_t)NUP + j0), ba = *(const f32x4*)(convb + j0);
                        const f32x4 w0b = *(const f32x4*)(convw + DFF + j0), w1b = *(const f32x4*)(convw + (size_t)NUP + DFF + j0), w2b = *(const f32x4*)(convw + 2 * (size_t)NUP + DFF + j0), bb = *(const f32x4*)(convb + DFF + j0);
                        const f32x4 y0a = ba + w2a * r0a + w1a * q5a + w0a * q4a, y0b = bb + w2b * r0b + w1b * q5b + w0b * q4b, y1a = ba + w2a * r1a + w1a * r0a + w0a * q5a, y1b = bb + w2b * r1b + w1b * r0b + w0b * q5b;
                        f32x4 o0, o1;
#pragma unroll
                        for (int e = 0; e < 4; ++e) { o0[e] = y0a[e] * sigmoidf_(y0a[e]) * y0b[e]; o1[e] = y1a[e] * sigmoidf_(y1a[e]) * y1b[e]; }
                        u32x2 w; w.x = pk2(o0[0], o0[1]); w.y = pk2(o0[2], o0[3]); *(u32x2*)(ACT + (size_t)(pm * 256) * DFF + j0) = w;
                        w.x = pk2(o1[0], o1[1]); w.y = pk2(o1[2], o1[3]); *(u32x2*)(ACT + (size_t)(pm * 256 + 1) * DFF + j0) = w; } } }
            if (pmA >= 0) { if (pmB < 0) pmB = pmA;
                const bool firstA = (pmA & 15) == 0, firstB = (pmB & 15) == 0; const float pzA = firstA ? 0.f : 1.f, pzB = firstB ? 0.f : 1.f;
                for (int it = tid; it < DFF / 4; it += NT_BLK) { const int j0 = it * 4; const int uc = 256 * (j0 >> 7) + 64 * ((j0 >> 5) & 3) + (j0 & 31);
                    const float* hA = HALO + (size_t)(pmA * 4) * NUP + uc; const float* gA = HALO + (size_t)((firstA ? pmA : pmA - 1) * 4) * NUP + uc;
                    const float* hB = HALO + (size_t)(pmB * 4) * NUP + uc; const float* gB = HALO + (size_t)((firstB ? pmB : pmB - 1) * 4) * NUP + uc;
                    const f32x4 A0a = *(const f32x4*)hA, A0b = *(const f32x4*)(hA + 32), A1a = *(const f32x4*)(hA + NUP), A1b = *(const f32x4*)(hA + NUP + 32);
                    const f32x4 A4a = *(const f32x4*)(gA + 2 * NUP), A4b = *(const f32x4*)(gA + 2 * NUP + 32), A5a = *(const f32x4*)(gA + 3 * NUP), A5b = *(const f32x4*)(gA + 3 * NUP + 32);
                    const f32x4 B0a = *(const f32x4*)hB, B0b = *(const f32x4*)(hB + 32), B1a = *(const f32x4*)(hB + NUP), B1b = *(const f32x4*)(hB + NUP + 32);
                    const f32x4 B4a = *(const f32x4*)(gB + 2 * NUP), B4b = *(const f32x4*)(gB + 2 * NUP + 32), B5a = *(const f32x4*)(gB + 3 * NUP), B5b = *(const f32x4*)(gB + 3 * NUP + 32);
                    const f32x4 w0a = *(const f32x4*)(convw + j0), w1a = *(const f32x4*)(convw + (size_t)NUP + j0), w2a = *(const f32x4*)(convw + 2 * (size_t)NUP + j0), ba = *(const f32x4*)(convb + j0);
                    const f32x4 w0b = *(const f32x4*)(convw + DFF + j0), w1b = *(const f32x4*)(convw + (size_t)NUP + DFF + j0), w2b = *(const f32x4*)(convw + 2 * (size_t)NUP + DFF + j0), bb = *(const f32x4*)(convb + DFF + j0);
                    const f32x4 qA4a = A4a * pzA, qA4b = A4b * pzA, qA5a = A5a * pzA, qA5b = A5b * pzA, qB4a = B4a * pzB, qB4b = B4b * pzB, qB5a = B5a * pzB, qB5b = B5b * pzB;
                    const f32x4 yA0a = ba + w2a * A0a + w1a * qA5a + w0a * qA4a, yA0b = bb + w2b * A0b + w1b * qA5b + w0b * qA4b, yA1a = ba + w2a * A1a + w1a * A0a + w0a * qA5a, yA1b = bb + w2b * A1b + w1b * A0b + w0b * qA5b;
                    const f32x4 yB0a = ba + w2a * B0a + w1a * qB5a + w0a * qB4a, yB0b = bb + w2b * B0b + w1b * qB5b + w0b * qB4b, yB1a = ba + w2a * B1a + w1a * B0a + w0a * qB5a, yB1b = bb + w2b * B1b + w1b * B0b + w0b * qB5b;
                    f32x4 oA0, oA1, oB0, oB1;
#pragma unroll
                    for (int e = 0; e < 4; ++e) { oA0[e] = yA0a[e] * sigmoidf_(yA0a[e]) * yA0b[e]; oA1[e] = yA1a[e] * sigmoidf_(yA1a[e]) * yA1b[e]; oB0[e] = yB0a[e] * sigmoidf_(yB0a[e]) * yB0b[e]; oB1[e] = yB1a[e] * sigmoidf_(yB1a[e]) * yB1b[e]; }
                    u32x2 w; w.x = pk2(oA0[0], oA0[1]); w.y = pk2(oA0[2], oA0[3]); *(u32x2*)(ACT + (size_t)(pmA * 256) * DFF + j0) = w;
                    w.x = pk2(oA1[0], oA1[1]); w.y = pk2(oA1[2], oA1[3]); *(u32x2*)(ACT + (size_t)(pmA * 256 + 1) * DFF + j0) = w;
                    w.x = pk2(oB0[0], oB0[1]); w.y = pk2(oB0[2], oB0[3]); *(u32x2*)(ACT + (size_t)(pmB * 256) * DFF + j0) = w;
                    w.x = pk2(oB1[0], oB1[1]); w.y = pk2(oB1[2], oB1[3]); *(u32x2*)(ACT + (size_t)(pmB * 256 + 1) * DFF + j0) = w; } } }
        asm volatile("s_waitcnt vmcnt(0)" ::: "memory"); __syncthreads();
        EpiResFromBf16 E{X1B, out, MODF + 5 * DM};
        pg8::gemm_phase<EpiResFromBf16, pg8::StaticOrder, true, PG8_SP2V>(lds, g, S, E);
    }
#undef IN
#undef SEAM
}

#ifndef MK_SPLIT
#define MK_SPLIT 0
#endif
constexpr int N_PHASES = 13;
extern "C" void kernel_launch(void* const* d_in, const int* in_sizes, int n_in, void* d_out, int out_size, void* d_ws, size_t ws_size, hipStream_t stream) {
    static int grid = 0;
    if (grid == 0) {
        if (n_in != 21 || out_size != M * DM || ws_size < WS_END) { fprintf(stderr, "kernel_launch: unexpected shapes n_in %d out %d ws %zu\n", n_in, out_size, ws_size); grid = -1; return; }
        int dev = 0, cus = 0, per_cu = 0;
        (void)hipGetDevice(&dev); (void)hipDeviceGetAttribute(&cus, hipDeviceAttributeMultiprocessorCount, dev);
        (void)hipFuncSetAttribute((const void*)fwd_kernel, hipFuncAttributeMaxDynamicSharedMemorySize, LDS_BYTES);
        (void)hipOccupancyMaxActiveBlocksPerMultiprocessor(&per_cu, (const void*)fwd_kernel, NT_BLK, LDS_BYTES);
        fprintf(stderr, "kernel_launch: cus %d per_cu %d ws %zu\n", cus, per_cu, ws_size);
        (void)hipGetLastError();
        grid = cus > 0 ? cus : 256;
    }
    if (grid < 0) return;
    (void)hipMemsetAsync(d_ws, 0, 65536, stream);
    Args a{};
    for (int i = 0; i < 21; ++i) a.in[i] = (const float*)d_in[i];
    a.out = (float*)d_out; a.ws = (unsigned char*)d_ws;
#if MK_SPLIT
    for (int p = 0; p < N_PHASES; ++p) { a.ph_lo = p; a.ph_hi = p + 1; void* args[] = {&a};
        hipError_t e = hipLaunchCooperativeKernel((const void*)fwd_kernel, dim3(grid), dim3(NT_BLK), args, LDS_BYTES, stream);
        if (e != hipSuccess) { fprintf(stderr, "launch %d failed: %s\n", p, hipGetErrorString(e)); break; } }
#else
    a.ph_lo = 0; a.ph_hi = N_PHASES; void* args[] = {&a};
    hipError_t e = hipLaunchCooperativeKernel((const void*)fwd_kernel, dim3(grid), dim3(NT_BLK), args, LDS_BYTES, stream);
    if (e != hipSuccess) fprintf(stderr, "cooperative launch failed: %s (grid %d)\n", hipGetErrorString(e), grid);
#endif
}
```
